# Optimizing an MI355X kernel written in HIP

```python
import math
import jax, jax.numpy as jnp
from jax import lax
import numpy as np

D_MODEL = 1024
BATCH = 16
SEQ = 4096
DEPTH = 1
DEC_BATCH = 16
DEC_SEQ = 32
PAST_LEN = 2048

CHUNK = 64
SSM_EXPAND = 2
D_INNER = SSM_EXPAND * D_MODEL
SSM_HEAD_DIM = 64
SSM_HEADS = D_INNER // SSM_HEAD_DIM
SSM_GROUPS = 8
SSM_HPG = SSM_HEADS // SSM_GROUPS
D_STATE = 128
SSM_CONV = 4
CONV_DIM = D_INNER + 2 * SSM_GROUPS * D_STATE
HEAD_DIM = 64
N_HEADS = D_MODEL // HEAD_DIM
N_KV_HEADS = 4
Q_PER_KV = N_HEADS // N_KV_HEADS
WINDOW = 128
PREV_CHUNKS = WINDOW // CHUNK
ROT_DIM = HEAD_DIM // 4
ROPE_THETA = 500000.0
D_FF = ((8 * D_MODEL // 3 + 255) // 256) * 256
FFN_CONV = 3
NORM_EPS = 1e-6

_IN_WIDTHS = (D_INNER, CONV_DIM, SSM_HEADS, N_HEADS * HEAD_DIM, N_KV_HEADS * HEAD_DIM, N_KV_HEADS * HEAD_DIM, 2 * D_MODEL)
IN_SPLITS = tuple(sum(_IN_WIDTHS[:i + 1]) for i in range(len(_IN_WIDTHS) - 1))
IN_WIDTH = sum(_IN_WIDTHS)

kernel_name = 'hybrid_ssd_swa_sink_convffn_stream_step'


def rmsnorm(x, g):
    xf = x.astype(jnp.float32)
    y = xf * lax.rsqrt(jnp.mean(xf * xf, axis=-1, keepdims=True) + NORM_EPS)
    return (y * g.astype(jnp.float32)).astype(x.dtype)


def partial_rope(x, pos):
    half = ROT_DIM // 2
    inv = ROPE_THETA ** (-jnp.arange(half, dtype=jnp.float32) / half)
    ang = pos.astype(jnp.float32)[:, None] * inv[None, :]
    cos, sin = jnp.cos(ang)[:, None, :], jnp.sin(ang)[:, None, :]
    xr = x[..., :ROT_DIM].astype(jnp.float32)
    x1, x2 = xr[..., :half], xr[..., half:]
    rot = jnp.concatenate([x1 * cos - x2 * sin, x2 * cos + x1 * sin], axis=-1)
    return jnp.concatenate([rot.astype(x.dtype), x[..., ROT_DIM:]], axis=-1)


def causal_dwconv(x, ctx, w, b):
    K, T = w.shape[0], x.shape[1]
    xp = jnp.concatenate([ctx.astype(x.dtype), x], axis=1)
    y = b
    for j in range(K):
        y = y + xp[:, j:j + T] * w[j]
    return y, xp[:, T:]


def ssd_chunk(h, inp):
    x, a, Bm, Cm = inp
    l = x.shape[1]
    acs = jnp.cumsum(a, axis=1)
    diff = acs[:, :, None] - acs[:, None, :]
    causal = jnp.tril(jnp.ones((l, l), dtype=bool))[None, :, :, None, None]
    decay = jnp.exp(jnp.where(causal, diff, -jnp.inf))
    cb = jnp.einsum('blgn,bsgn->blsg', Cm, Bm)
    y = jnp.einsum('blsgr,bsgrp->blgrp', cb[..., None] * decay, x)
    y = y + jnp.einsum('blgn,bgrpn->blgrp', Cm, h) * jnp.exp(acs)[..., None]
    xt = x * jnp.exp(acs[:, -1:] - acs)[..., None]
    h = h * jnp.exp(acs[:, -1])[..., None, None] + jnp.einsum('blgn,blgrp->bgrpn', Bm, xt)
    return h, y


def ssd_scan(x, a, Bm, Cm, h0):
    b, T = x.shape[0], x.shape[1]
    L = min(CHUNK, T)
    nc = T // L
    def blocks(t):
        return jnp.moveaxis(t.reshape((b, nc, L) + t.shape[2:]), 1, 0)
    h, y = lax.scan(ssd_chunk, h0, (blocks(x), blocks(a), blocks(Bm), blocks(Cm)))
    return jnp.moveaxis(y, 0, 1).reshape(x.shape), h


def ssm_branch(z, xbc, dt, conv_ctx, h0, p):
    b, T = z.shape[0], z.shape[1]
    xbc, conv_new = causal_dwconv(xbc, conv_ctx, p['ssm_conv_w'], p['ssm_conv_b'])
    xbc = jax.nn.silu(xbc).astype(jnp.float32)
    xs, Bm, Cm = jnp.split(xbc, [D_INNER, D_INNER + SSM_GROUPS * D_STATE], axis=-1)
    xs = xs.reshape(b, T, SSM_GROUPS, SSM_HPG, SSM_HEAD_DIM)
    Bm = Bm.reshape(b, T, SSM_GROUPS, D_STATE)
    Cm = Cm.reshape(b, T, SSM_GROUPS, D_STATE)
    dt = jax.nn.softplus(dt.astype(jnp.float32) + p['ssm_dt_bias'].astype(jnp.float32))
    dt = dt.reshape(b, T, SSM_GROUPS, SSM_HPG)
    A = -jnp.exp(p['ssm_a_log'].astype(jnp.float32)).reshape(SSM_GROUPS, SSM_HPG)
    h0 = h0.astype(jnp.float32).reshape(b, SSM_GROUPS, SSM_HPG, SSM_HEAD_DIM, D_STATE)
    y, h = ssd_scan(xs * dt[..., None], dt * A, Bm, Cm, h0)
    y = y + xs * p['ssm_d'].astype(jnp.float32).reshape(SSM_GROUPS, SSM_HPG)[..., None]
    y = y.reshape(b, T, D_INNER) * jax.nn.silu(z.astype(jnp.float32))
    yg = y.reshape(b, T, SSM_GROUPS, D_INNER // SSM_GROUPS)
    yg = yg * lax.rsqrt(jnp.mean(yg * yg, axis=-1, keepdims=True) + NORM_EPS)
    y = yg.reshape(b, T, D_INNER) * p['ssm_norm'].astype(jnp.float32)
    h = h.reshape(b, SSM_HEADS, SSM_HEAD_DIM, D_STATE)
    return y.astype(z.dtype), conv_new, h.astype(z.dtype)


def sink_softmax(s, sink):
    m = jnp.maximum(jnp.max(s, axis=-1, keepdims=True), sink)
    e = jnp.exp(s - m)
    return e / (jnp.sum(e, axis=-1, keepdims=True) + jnp.exp(sink - m))


def swa_prompt(q, k, v, sinks):
    b, T = q.shape[0], q.shape[1]
    nc = T // CHUNK
    qc = q.reshape(b, nc, CHUNK, N_KV_HEADS, Q_PER_KV, HEAD_DIM)
    def band(t):
        tc = t.reshape(b, nc, CHUNK, N_KV_HEADS, HEAD_DIM)
        tp = jnp.pad(tc, ((0, 0), (PREV_CHUNKS, 0), (0, 0), (0, 0), (0, 0)))
        return jnp.concatenate([tp[:, i:i + nc] for i in range(PREV_CHUNKS + 1)], axis=2)
    kb, vb = band(k), band(v)
    s = jnp.einsum('bcqkrd,bcskd->bckrqs', qc, kb, preferred_element_type=jnp.float32) * (HEAD_DIM ** -0.5)
    key_chunk = jnp.arange(nc)[:, None] + (jnp.arange((PREV_CHUNKS + 1) * CHUNK) // CHUNK - PREV_CHUNKS)[None, :]
    valid = (key_chunk >= 0)[None, :, None, None, None, :]
    s = jnp.where(valid, s, jnp.finfo(jnp.float32).min)
    pr = sink_softmax(s, sinks)
    o = jnp.einsum('bckrqs,bcskd->bcqkrd', pr.astype(v.dtype), vb)
    return o.reshape(b, T, N_HEADS * HEAD_DIM)


def swa_cached(q, k, v, cache_k, cache_v, sinks):
    b, S = q.shape[0], q.shape[1]
    kk = jnp.concatenate([cache_k.astype(k.dtype), k], axis=1)
    vv = jnp.concatenate([cache_v.astype(v.dtype), v], axis=1)
    qg = q.reshape(b, S, N_KV_HEADS, Q_PER_KV, HEAD_DIM)
    s = jnp.einsum('bqkrd,bskd->bkrqs', qg, kk, preferred_element_type=jnp.float32) * (HEAD_DIM ** -0.5)
    pr = sink_softmax(s, sinks)
    o = jnp.einsum('bkrqs,bskd->bqkrd', pr.astype(vv.dtype), vv).reshape(b, S, N_HEADS * HEAD_DIM)
    rows = cache_k.shape[1]
    return o, kk[:, -rows:], vv[:, -rows:]


def layer(x, c, pos, conv_ctx, h0, kv_ctx, ffn_ctx, p):
    b, T = x.shape[0], x.shape[1]
    mod = jax.nn.silu(c) @ p['w_ada'] + p['b_ada']
    sh1, sc1, g1, sh2, sc2, g2 = jnp.split(mod[:, None, :], 6, axis=-1)
    hn = rmsnorm(x, p['norm_mix_pre']) * (1 + sc1) + sh1
    proj = hn @ p['w_in']
    z, xbc, dt, q, k, v, gates = jnp.split(proj, IN_SPLITS, axis=-1)
    y_ssm, conv_new, h_new = ssm_branch(z, xbc, dt, conv_ctx, h0, p)
    q = partial_rope(q.reshape(b, T, N_HEADS, HEAD_DIM), pos)
    k = partial_rope(k.reshape(b, T, N_KV_HEADS, HEAD_DIM), pos)
    v = v.reshape(b, T, N_KV_HEADS, HEAD_DIM)
    sinks = p['attn_sinks'].astype(jnp.float32).reshape(N_KV_HEADS, Q_PER_KV, 1, 1)
    if kv_ctx is None:
        y_att = swa_prompt(q, k, v, sinks)
        rows = min(WINDOW, PAST_LEN)
        k_new, v_new = k[:, -rows:], v[:, -rows:]
    else:
        y_att, k_new, v_new = swa_cached(q, k, v, kv_ctx[0], kv_ctx[1], sinks)
    g_ssm, g_att = jnp.split(jax.nn.sigmoid(gates), 2, axis=-1)
    merged = g_ssm * (y_ssm @ p['w_ssm_out']) + g_att * (y_att @ p['w_att_out'])
    x = x + g1 * rmsnorm(merged @ p['w_out'], p['norm_mix_post'])
    hn = rmsnorm(x, p['norm_ffn_pre']) * (1 + sc2) + sh2
    gate, up = jnp.split(hn @ p['w_ffn_in'], 2, axis=-1)
    gate, ffn_new = causal_dwconv(gate, ffn_ctx, p['ffn_conv_w'], p['ffn_conv_b'])
    f = (jax.nn.silu(gate) * up) @ p['w_ffn_out']
    x = x + g2 * rmsnorm(f, p['norm_ffn_post'])
    return x, (h_new, conv_new, k_new, v_new, ffn_new)


def setup_inputs(seed: int = 0) -> dict:
    key = jax.random.key(seed)
    ks = jax.random.split(key, 40)
    f32 = jnp.float32
    def nrm(i, shape, scale):
        return jax.random.normal(ks[i], shape, f32) * scale
    def gain(i, shape):
        return 1.0 + 0.05 * jax.random.normal(ks[i], shape, f32)
    rows = min(WINDOW, PAST_LEN)
    dt0 = jnp.exp(jax.random.uniform(ks[30], (DEPTH, SSM_HEADS), f32, math.log(1e-3), math.log(1e-1)))
    return {
        'x_prompt': nrm(0, (BATCH, SEQ, D_MODEL), 1.0),
        'x_sample': nrm(1, (DEC_BATCH, DEC_SEQ, D_MODEL), 1.0),
        'cache_k': nrm(2, (DEPTH, DEC_BATCH, rows, N_KV_HEADS, HEAD_DIM), 1.0),
        'cache_v': nrm(3, (DEPTH, DEC_BATCH, rows, N_KV_HEADS, HEAD_DIM), 1.0),
        'state_ssm': nrm(4, (DEPTH, DEC_BATCH, SSM_HEADS, SSM_HEAD_DIM, D_STATE), 0.1),
        'state_conv': nrm(5, (DEPTH, DEC_BATCH, SSM_CONV - 1, CONV_DIM), 1.0),
        'state_ffn_conv': nrm(6, (DEPTH, DEC_BATCH, FFN_CONV - 1, D_FF), 1.0),
        'c_prompt': nrm(7, (BATCH, D_MODEL), 1.0),
        'c_sample': nrm(8, (DEC_BATCH, D_MODEL), 1.0),
        'w_ada': nrm(9, (DEPTH, D_MODEL, 6 * D_MODEL), 0.5 * D_MODEL ** -0.5),
        'b_ada': nrm(10, (DEPTH, 6 * D_MODEL), 0.02),
        'norm_mix_pre': gain(11, (DEPTH, D_MODEL)),
        'norm_mix_post': gain(12, (DEPTH, D_MODEL)),
        'w_in': nrm(13, (DEPTH, D_MODEL, IN_WIDTH), D_MODEL ** -0.5),
        'ssm_conv_w': nrm(14, (DEPTH, SSM_CONV, CONV_DIM), SSM_CONV ** -0.5),
        'ssm_conv_b': nrm(15, (DEPTH, CONV_DIM), 0.02),
        'ssm_dt_bias': dt0 + jnp.log(-jnp.expm1(-dt0)),
        'ssm_a_log': jnp.log(jax.random.uniform(ks[16], (DEPTH, SSM_HEADS), f32, 1.0, 16.0)),
        'ssm_d': gain(17, (DEPTH, SSM_HEADS)),
        'ssm_norm': gain(18, (DEPTH, D_INNER)),
        'attn_sinks': nrm(19, (DEPTH, N_HEADS), 0.5),
        'w_ssm_out': nrm(20, (DEPTH, D_INNER, D_MODEL), D_INNER ** -0.5),
        'w_att_out': nrm(21, (DEPTH, N_HEADS * HEAD_DIM, D_MODEL), (N_HEADS * HEAD_DIM) ** -0.5),
        'w_out': nrm(22, (DEPTH, D_MODEL, D_MODEL), D_MODEL ** -0.5),
        'norm_ffn_pre': gain(23, (DEPTH, D_MODEL)),
        'norm_ffn_post': gain(24, (DEPTH, D_MODEL)),
        'w_ffn_in': nrm(25, (DEPTH, D_MODEL, 2 * D_FF), D_MODEL ** -0.5),
        'ffn_conv_w': nrm(26, (DEPTH, FFN_CONV, D_FF), FFN_CONV ** -0.5),
        'ffn_conv_b': nrm(27, (DEPTH, D_FF), 0.02),
        'w_ffn_out': nrm(28, (DEPTH, D_FF, D_MODEL), D_FF ** -0.5),
    }


def reference(x_prompt, x_sample, cache_k, cache_v, state_ssm, state_conv, state_ffn_conv, c_prompt, c_sample,
              w_ada, b_ada, norm_mix_pre, norm_mix_post, w_in, ssm_conv_w, ssm_conv_b, ssm_dt_bias, ssm_a_log,
              ssm_d, ssm_norm, attn_sinks, w_ssm_out, w_att_out, w_out, norm_ffn_pre, norm_ffn_post,
              w_ffn_in, ffn_conv_w, ffn_conv_b, w_ffn_out):
    bp, tp = x_prompt.shape[0], x_prompt.shape[1]
    pos_p = jnp.arange(tp)
    pos_s = PAST_LEN + jnp.arange(x_sample.shape[1])
    yp, ys = x_prompt, x_sample
    st_p, st_s = [], []
    for l in range(DEPTH):
        p = {
            'w_ada': w_ada[l], 'b_ada': b_ada[l], 'norm_mix_pre': norm_mix_pre[l], 'norm_mix_post': norm_mix_post[l],
            'w_in': w_in[l], 'ssm_conv_w': ssm_conv_w[l], 'ssm_conv_b': ssm_conv_b[l], 'ssm_dt_bias': ssm_dt_bias[l],
            'ssm_a_log': ssm_a_log[l], 'ssm_d': ssm_d[l], 'ssm_norm': ssm_norm[l], 'attn_sinks': attn_sinks[l],
            'w_ssm_out': w_ssm_out[l], 'w_att_out': w_att_out[l], 'w_out': w_out[l],
            'norm_ffn_pre': norm_ffn_pre[l], 'norm_ffn_post': norm_ffn_post[l], 'w_ffn_in': w_ffn_in[l],
            'ffn_conv_w': ffn_conv_w[l], 'ffn_conv_b': ffn_conv_b[l], 'w_ffn_out': w_ffn_out[l],
        }
        conv0 = jnp.zeros((bp, SSM_CONV - 1, CONV_DIM), x_prompt.dtype)
        h0 = jnp.zeros((bp, SSM_HEADS, SSM_HEAD_DIM, D_STATE), jnp.float32)
        ffn0 = jnp.zeros((bp, FFN_CONV - 1, D_FF), x_prompt.dtype)
        yp, sp = layer(yp, c_prompt, pos_p, conv0, h0, None, ffn0, p)
        ys, ss = layer(ys, c_sample, pos_s, state_conv[l], state_ssm[l], (cache_k[l], cache_v[l]), state_ffn_conv[l], p)
        st_p.append(sp)
        st_s.append(ss)
    ssm_p, conv_p, k_p, v_p, ffn_p = [jnp.stack(t) for t in zip(*st_p)]
    ssm_s, conv_s, k_s, v_s, ffn_s = [jnp.stack(t) for t in zip(*st_s)]
    return (yp, ys, ssm_p, conv_p, k_p, v_p, ffn_p, ssm_s, conv_s, k_s, v_s, ffn_s)
```

```cpp
#include <hip/hip_runtime.h>
#include <hip/hip_cooperative_groups.h>
#include <cstdio>
#include <cstdint>
namespace cg = cooperative_groups;
namespace pg8 {
#define PG8_LAS __attribute__((address_space(3)))
typedef unsigned short bf16_t;
typedef short bf16x8 __attribute__((ext_vector_type(8)));
typedef float f32x4 __attribute__((ext_vector_type(4)));
typedef unsigned u32x4 __attribute__((ext_vector_type(4)));
constexpr int BM = 256, BK = 64, HALF = 128, HTB = HALF * BK * 2  , STAGE_BYTES = 8 * HTB, NXCD = 8, WGM = 8;

__host__ __device__ __forceinline__ int lds_byte(int r, int c) { const int st = (r >> 4) * 2 + (c >> 5), rr = r & 15, cc = c & 31, ob = rr * 64 + cc * 2; return st * 1024 + (ob ^ (((ob >> 9) & 1) << 5)); }
__host__ __device__ __forceinline__ void stage_rc(int b, int& R, int& C) { const int st = b / 1024, sb = b % 1024, swz = sb ^ (((sb >> 9) & 1) << 5); R = (st >> 1) * 16 + swz / 64; C = (st & 1) * 32 + (swz % 64) / 2; }
__host__ __device__ __forceinline__ int perm32(int rho) { const int n = rho >> 4, i = rho & 15; return 8 * (i >> 2) + 4 * n + (i & 3); }

struct Unit { int pm, pn; };
struct Gemm { const bf16_t* A; const bf16_t* Bt; int M, N, K; };

struct StaticOrder {
    int nM, nN, nwg, G, c, wgm = 8;
    __host__ __device__ __forceinline__ void init(int M, int N, int G_, int c_) { nM = M / BM; nN = N / BM; nwg = nM * nN; G = G_; c = c_; }
    __host__ __device__ __forceinline__ bool next(int i, Unit& u) const {
        const long L = (long)i * G + c; if (L >= nwg) return false;
        int wgid = (int)L; { const int q = nwg / NXCD, r = nwg % NXCD, xcd = wgid % NXCD, off = wgid / NXCD; wgid = (xcd < r ? xcd * (q + 1) : r * (q + 1) + (xcd - r) * q) + off; }
        const int nig = wgm * nN, gid = wgid / nig, fm = gid * wgm, gsz = (nM - fm) < wgm ? (nM - fm) : wgm;
        u.pm = fm + ((wgid % nig) % gsz); u.pn = (wgid % nig) / gsz; return true;
    }
    __device__ __forceinline__ void a_ready(const Unit&) const {}
    __device__ __forceinline__ void done(const Unit&) const {}
};
template <class Epi, class Sched, bool ALIGN_EPI = false, bool SP2 = false>
__device__ __forceinline__ void gemm_phase(PG8_LAS unsigned char* lds, const Gemm g, const Sched& S, const Epi& E) {
    int tid_l = threadIdx.x; asm volatile("" : "+v"(tid_l));
    const int tid = tid_l, wid = __builtin_amdgcn_readfirstlane(tid >> 6), lane = tid & 63, wr = wid >> 2, wc = wid & 3, fr = lane & 15, fq = lane >> 4;
    const int K = g.K, nt = K / BK;
    unsigned voffA[2], voffB[2];
#pragma unroll
    for (int i = 0; i < 2; ++i) { int R, C; stage_rc(tid * 16 + i * 8192, R, C); const int Rb = Epi::PERM ? ((R & ~31) + perm32(R & 31)) : R;
        voffA[i] = (unsigned)(R * K + C) * 2u; voffB[i] = (unsigned)(Rb * K + C) * 2u; }
    const size_t kstep = (size_t)(BK * 2);
    const size_t hstep = (size_t)HALF * K * 2;
    const size_t tstep = 2 * hstep;
    const unsigned ldsw = (unsigned)wid * 1024u;
    const int aoff = lds_byte(wr * 64 + fr, fq * 8), boff = lds_byte(wc * 32 + fr, fq * 8);
#define PG8_SA(b, h) (((b) * 2 + (h)) * HTB)
#define PG8_SB(b, h) ((4 + (b) * 2 + (h)) * HTB)
#define PG8_STAGE(bufoff, gbase, voff) do { _Pragma("unroll") for (int _i = 0; _i < 2; ++_i) \
        __builtin_amdgcn_global_load_lds((const unsigned*)((const char*)(gbase) + (voff)[_i]), (PG8_LAS unsigned*)(lds + (bufoff) + ldsw + _i * 8192), 16, 0, 0); } while (0)
#define PG8_LDA(dst, b, h) do { _Pragma("unroll") for (int m = 0; m < 4; ++m) _Pragma("unroll") for (int k = 0; k < 2; ++k) dst[m][k] = *(const PG8_LAS bf16x8*)(lds + PG8_SA(b, h) + aoff + m * 2048 + k * 1024); } while (0)
#define PG8_LDB(dst, b, h) do { _Pragma("unroll") for (int n = 0; n < 2; ++n) _Pragma("unroll") for (int k = 0; k < 2; ++k) dst[n][k] = *(const PG8_LAS bf16x8*)(lds + PG8_SB(b, h) + boff + n * 2048 + k * 1024); } while (0)
#define PG8_MMA(ai, bj, At, Bt) do { __builtin_amdgcn_s_setprio(1); _Pragma("unroll") for (int m = 0; m < 4; ++m) _Pragma("unroll") for (int n = 0; n < 2; ++n) _Pragma("unroll") for (int k = 0; k < 2; ++k) \
        acc[ai][bj][m][n] = __builtin_amdgcn_mfma_f32_16x16x32_bf16(Bt[n][k], At[m][k], acc[ai][bj][m][n], 0, 0, 0); __builtin_amdgcn_s_setprio(0); } while (0)
#define PG8_WAIT_V(n) asm volatile("s_waitcnt vmcnt(" #n ")" ::: "memory")
#define PG8_WAIT_L(n) asm volatile("s_waitcnt lgkmcnt(" #n ")" ::: "memory")
#define PG8_BAR __builtin_amdgcn_s_barrier()
#define PG8_SCHED __builtin_amdgcn_sched_barrier(0)
    Unit cur, nxt; int ui = 0;
    if (!S.next(0, cur)) return;
    f32x4 acc[2][2][4][2];
#pragma unroll
    for (int a = 0; a < 2; ++a)
#pragma unroll
        for (int b = 0; b < 2; ++b)
#pragma unroll
            for (int m = 0; m < 4; ++m)
#pragma unroll
                for (int n = 0; n < 2; ++n) acc[a][b][m][n] = (f32x4){0.f, 0.f, 0.f, 0.f};
    bf16x8 At[4][2], B0[2][2], B1[2][2];
    const char* cA = (const char*)g.A + (size_t)cur.pm * tstep; const char* cB = (const char*)g.Bt + (size_t)cur.pn * tstep;
    S.a_ready(cur);
    if constexpr (SP2) {
        PG8_STAGE(PG8_SB(0, 0), cB, voffB); PG8_STAGE(PG8_SB(0, 1), cB + hstep, voffB); PG8_STAGE(PG8_SA(0, 0), cA, voffA); PG8_STAGE(PG8_SA(0, 1), cA + hstep, voffA);
        if (wr == 1) PG8_BAR;
        PG8_WAIT_V(2); PG8_BAR;
        PG8_STAGE(PG8_SB(1, 0), cB + kstep, voffB); PG8_STAGE(PG8_SA(1, 0), cA + kstep, voffA); PG8_STAGE(PG8_SB(1, 1), cB + hstep + kstep, voffB);
        PG8_WAIT_V(6); PG8_BAR;
    } else {
        PG8_STAGE(PG8_SB(0, 0), cB, voffB); PG8_STAGE(PG8_SA(0, 0), cA, voffA); PG8_STAGE(PG8_SB(0, 1), cB + hstep, voffB); PG8_STAGE(PG8_SA(0, 1), cA + hstep, voffA);
        if (wr == 1) PG8_BAR;
        PG8_WAIT_V(4); PG8_BAR;
        PG8_STAGE(PG8_SB(1, 0), cB + kstep, voffB); PG8_STAGE(PG8_SA(1, 0), cA + kstep, voffA); PG8_STAGE(PG8_SB(1, 1), cB + hstep + kstep, voffB);
        PG8_WAIT_V(6); PG8_BAR;
    }
    for (;;) {
        const bool has_next = S.next(ui + 1, nxt);
        const char* nA = has_next ? (const char*)g.A + (size_t)nxt.pm * tstep : cA; const char* nB = has_next ? (const char*)g.Bt + (size_t)nxt.pn * tstep : cB;
        for (int t = 0; t < nt; t += 2) {
            const bool last = (t == nt - 2);
            const char* a1 = cA + (size_t)(t + 1) * kstep;
            const char* a2 = last ? nA : cA + (size_t)(t + 2) * kstep; const char* b2 = last ? nB : cB + (size_t)(t + 2) * kstep;
            const char* a3 = a2 + kstep; const char* b3 = b2 + kstep;
            if (last && has_next) S.a_ready(nxt);
            if constexpr (SP2) {
            PG8_LDB(B0, 0, 0); PG8_LDB(B1, 0, 1); PG8_SCHED; PG8_LDA(At, 0, 0); PG8_STAGE(PG8_SA(1, 1), a1 + hstep, voffA);
            PG8_WAIT_V(8); PG8_WAIT_L(0); PG8_BAR; PG8_MMA(0, 0, At, B0); PG8_MMA(0, 1, At, B1); PG8_BAR; PG8_SCHED;
            PG8_LDA(At, 0, 1); PG8_STAGE(PG8_SB(0, 0), b2, voffB); PG8_STAGE(PG8_SB(0, 1), b2 + hstep, voffB); PG8_STAGE(PG8_SA(0, 0), a2, voffA);
            PG8_WAIT_V(8); PG8_WAIT_L(0); PG8_BAR; PG8_MMA(1, 0, At, B0); PG8_MMA(1, 1, At, B1); PG8_BAR; PG8_SCHED;
            PG8_LDB(B0, 1, 0); PG8_LDB(B1, 1, 1); PG8_SCHED; PG8_LDA(At, 1, 0); PG8_STAGE(PG8_SA(0, 1), a2 + hstep, voffA);
            PG8_WAIT_V(8); PG8_WAIT_L(0); PG8_BAR; PG8_MMA(0, 0, At, B0); PG8_MMA(0, 1, At, B1); PG8_BAR; PG8_SCHED;
            PG8_LDA(At, 1, 1); PG8_STAGE(PG8_SB(1, 0), b3, voffB); PG8_STAGE(PG8_SB(1, 1), b3 + hstep, voffB); PG8_STAGE(PG8_SA(1, 0), a3, voffA);
            PG8_WAIT_V(8); PG8_WAIT_L(0); PG8_BAR; PG8_MMA(1, 0, At, B0); PG8_MMA(1, 1, At, B1); PG8_BAR; PG8_SCHED;
            } else {
            PG8_LDB(B0, 0, 0); PG8_SCHED; PG8_LDA(At, 0, 0); PG8_STAGE(PG8_SA(1, 1), a1 + hstep, voffA);
            PG8_WAIT_L(8); PG8_BAR; PG8_WAIT_L(0); PG8_MMA(0, 0, At, B0); PG8_BAR; PG8_SCHED;
            PG8_LDB(B1, 0, 1); PG8_STAGE(PG8_SB(0, 0), b2, voffB);
            PG8_BAR; PG8_WAIT_L(0); PG8_MMA(0, 1, At, B1); PG8_BAR;
            PG8_LDA(At, 0, 1); PG8_STAGE(PG8_SA(0, 0), a2, voffA);
            PG8_BAR; PG8_WAIT_L(0); PG8_MMA(1, 0, At, B0); PG8_BAR; PG8_SCHED;
            PG8_STAGE(PG8_SB(0, 1), b2 + hstep, voffB);
            PG8_WAIT_V(6); PG8_BAR; PG8_MMA(1, 1, At, B1); PG8_BAR;
            PG8_LDB(B0, 1, 0); PG8_SCHED; PG8_LDA(At, 1, 0); PG8_STAGE(PG8_SA(0, 1), a2 + hstep, voffA);
            PG8_WAIT_L(8); PG8_BAR; PG8_WAIT_L(0); PG8_MMA(0, 0, At, B0); PG8_BAR; PG8_SCHED;
            PG8_LDB(B1, 1, 1); PG8_STAGE(PG8_SB(1, 0), b3, voffB);
            PG8_BAR; PG8_WAIT_L(0); PG8_MMA(0, 1, At, B1); PG8_BAR;
            PG8_LDA(At, 1, 1); PG8_STAGE(PG8_SA(1, 0), a3, voffA);
            PG8_BAR; PG8_WAIT_L(0); PG8_MMA(1, 0, At, B0); PG8_BAR; PG8_SCHED;
            PG8_STAGE(PG8_SB(1, 1), b3 + hstep, voffB);
            PG8_WAIT_V(6); PG8_BAR; PG8_MMA(1, 1, At, B1); PG8_BAR;
            }
        }
        if constexpr (ALIGN_EPI) { if (wr == 0) PG8_BAR; }
        if constexpr (!Epi::AFTER_DRAIN) { E(acc, cur, wr, wc, fr, fq); S.done(cur); }
        if (!has_next) break;
#pragma unroll
        for (int a = 0; a < 2; ++a)
#pragma unroll
            for (int b = 0; b < 2; ++b)
#pragma unroll
                for (int m = 0; m < 4; ++m)
#pragma unroll
                    for (int n = 0; n < 2; ++n) acc[a][b][m][n] = (f32x4){0.f, 0.f, 0.f, 0.f};
        cur = nxt; cA = nA; cB = nB; ++ui;
        if constexpr (ALIGN_EPI) { if (wr == 1) PG8_BAR; }
    }
    PG8_WAIT_V(0);
    if constexpr (!ALIGN_EPI) { if (wr == 0) PG8_BAR; }
    PG8_BAR;
    if constexpr (Epi::AFTER_DRAIN) { E.fused(acc, cur, wr, wc, fr, fq, lds, wid, lane); S.done(cur); }
#undef PG8_SA
#undef PG8_SB
#undef PG8_STAGE
#undef PG8_LDA
#undef PG8_LDB
#undef PG8_MMA
#undef PG8_WAIT_V
#undef PG8_WAIT_L
#undef PG8_BAR
#undef PG8_SCHED
}
}

#define DI __device__ __forceinline__
#define LAS __attribute__((address_space(3)))
typedef unsigned short bf16_t;
typedef short bf16x8 __attribute__((ext_vector_type(8)));
typedef float f32x4 __attribute__((ext_vector_type(4)));
typedef float f32x16 __attribute__((ext_vector_type(16)));
typedef unsigned u32x4 __attribute__((ext_vector_type(4)));
typedef unsigned u32x2 __attribute__((ext_vector_type(2)));
typedef float f32x2_t __attribute__((ext_vector_type(2)));
typedef __bf16 bf16x2_t __attribute__((ext_vector_type(2)));

constexpr int DM = 1024, SEQ = 4096, PROWS = 65536, SROWS = 512;
constexpr int G_BASE1 = 32768, RG = 33280;
constexpr int NPROJ = 9984, DFF = 2816;
constexpr float EPS = 1e-6f;

constexpr size_t OFF_WIN = 0;
constexpr size_t OFF_WSSM = OFF_WIN + (size_t)NPROJ * 1024 * 2;
constexpr size_t OFF_WATT = OFF_WSSM + (size_t)1024 * 2048 * 2;
constexpr size_t OFF_WOUT = OFF_WATT + (size_t)1024 * 1024 * 2;
constexpr size_t OFF_WFIN = OFF_WOUT + (size_t)1024 * 1024 * 2;
constexpr size_t OFF_WFOUT = OFF_WFIN + (size_t)5632 * 1024 * 2;
constexpr size_t OFF_MOD = OFF_WFOUT + (size_t)1024 * 2816 * 2;
constexpr size_t OFF_ROPE = OFF_MOD + (size_t)32 * 6144 * 4;
constexpr size_t OFF_HN = OFF_ROPE + (size_t)4128 * 16 * 4;
constexpr size_t OFF_Z = OFF_HN + (size_t)RG * 1024 * 2;
constexpr size_t OFF_GT = OFF_Z + (size_t)RG * 2048 * 2;
constexpr size_t OFF_XBC = OFF_GT + (size_t)RG * 2048 * 2;
constexpr size_t OFF_Q = OFF_XBC + (size_t)RG * 4096 * 2;
constexpr size_t OFF_K = OFF_Q + (size_t)RG * 1024 * 2;
constexpr size_t OFF_V = OFF_K + (size_t)RG * 256 * 2;
constexpr size_t OFF_DT = OFF_V + (size_t)RG * 256 * 2;
constexpr size_t OFF_YS = OFF_DT + (size_t)RG * 32 * 4;
constexpr size_t OFF_HALO = OFF_YS + (size_t)RG * 2048 * 2;
constexpr size_t OFF_SSF = OFF_HALO + (size_t)(RG / 64) * 3 * 4096 * 2;
constexpr size_t OFF_SSDK = OFF_SSF + (size_t)8 * 8 * 3 * 4 * 8192 * 4;
constexpr size_t OFF_BAR = OFF_SSDK + 4096;
constexpr size_t WS_END = OFF_BAR + 16384;
constexpr size_t OFF_T1 = OFF_XBC;
constexpr size_t OFF_MRG = OFF_HN;
constexpr size_t OFF_O = OFF_Z;
constexpr size_t OFF_GR = OFF_XBC;
constexpr size_t OFF_ACT = OFF_Z;
constexpr size_t OFF_F = OFF_YS;
static_assert(OFF_HN % 256 == 0 && OFF_Z % 256 == 0 && OFF_XBC % 256 == 0 && OFF_YS % 256 == 0, "align");
static_assert((size_t)RG * 2816 * 2 <= (size_t)RG * 4096 * 2, "GR fits XBC");

constexpr size_t OUT_Y = 0;
constexpr size_t OUT_SSM_P = 67108864ull + 524288ull;
constexpr size_t OUT_CONV_P = OUT_SSM_P + 4194304ull;
constexpr size_t OUT_K_P = OUT_CONV_P + 196608ull;
constexpr size_t OUT_V_P = OUT_K_P + 524288ull;
constexpr size_t OUT_FFN_P = OUT_V_P + 524288ull;
constexpr size_t OUT_SSM_S = OUT_FFN_P + 90112ull;
constexpr size_t OUT_CONV_S = OUT_SSM_S + 4194304ull;
constexpr size_t OUT_K_S = OUT_CONV_S + 196608ull;
constexpr size_t OUT_V_S = OUT_K_S + 524288ull;
constexpr size_t OUT_FFN_S = OUT_V_S + 524288ull;
constexpr size_t OUT_TOTAL = OUT_FFN_S + 90112ull;

constexpr int LDS_BYTES = 132096;

struct Params {
    const float* x_prompt; const float* x_sample; const float* cache_k; const float* cache_v; const float* state_ssm; const float* state_conv;
    const float* state_ffn; const float* c_prompt; const float* c_sample; const float* w_ada; const float* b_ada; const float* norm_mix_pre;
    const float* norm_mix_post; const float* w_in; const float* ssm_conv_w; const float* ssm_conv_b; const float* ssm_dt_bias; const float* ssm_a_log;
    const float* ssm_d; const float* ssm_norm; const float* attn_sinks; const float* w_ssm_out; const float* w_att_out; const float* w_out;
    const float* norm_ffn_pre; const float* norm_ffn_post; const float* w_ffn_in; const float* ffn_conv_w; const float* ffn_conv_b; const float* w_ffn_out;
    float* out; unsigned char* ws;
};

DI unsigned pk2(float lo, float hi) { f32x2_t v = {lo, hi}; bf16x2_t b = __builtin_convertvector(v, bf16x2_t); return __builtin_bit_cast(unsigned, b); }
DI bf16_t f2bf(float f) { return (bf16_t)(pk2(f, 0.f) & 0xffffu); }
DI float bf2f(unsigned u16) { return __uint_as_float(u16 << 16); }
DI float bflo(unsigned w) { return __uint_as_float(w << 16); }
DI float bfhi(unsigned w) { return __uint_as_float(w & 0xffff0000u); }
DI u32x4 pack8f(const float* v) { u32x4 r; r.x = pk2(v[0], v[1]); r.y = pk2(v[2], v[3]); r.z = pk2(v[4], v[5]); r.w = pk2(v[6], v[7]); return r; }
DI float silu_f(float v) { return v * __builtin_amdgcn_rcpf(1.f + __expf(-v)); }
DI float sigmoid_f(float v) { return __builtin_amdgcn_rcpf(1.f + __expf(-v)); }
DI float wave_sum(float v) {
#pragma unroll
    for (int o = 1; o < 64; o <<= 1) v += __shfl_xor(v, o);
    return v;
}
DI void row_info(int grow, int& b, int& t, int& smp) {
    if (grow < PROWS) { b = grow >> 12; t = grow & 4095; smp = 0; } else { const int rr = grow - PROWS; b = rr >> 5; t = rr & 31; smp = 1; }
}
#define MFMA32(a, b, c) __builtin_amdgcn_mfma_f32_32x32x16_bf16((a), (b), (c), 0, 0, 0)
DI bf16x8 ld2x8(const LAS unsigned char* p) {
    const u32x2 lo = *(const LAS u32x2*)p; const u32x2 hi = *(const LAS u32x2*)(p + 16);
    u32x4 r; r.x = lo.x; r.y = lo.y; r.z = hi.x; r.w = hi.y; return __builtin_bit_cast(bf16x8, r);
}
#define PACK8(x, s) __builtin_bit_cast(bf16x8, (u32x4){pk2((x)[8 * (s)], (x)[8 * (s) + 1]), pk2((x)[8 * (s) + 2], (x)[8 * (s) + 3]), pk2((x)[8 * (s) + 4], (x)[8 * (s) + 5]), pk2((x)[8 * (s) + 6], (x)[8 * (s) + 7])})

#define EPI_LOOP_BEGIN \
    _Pragma("unroll") for (int ai = 0; ai < 2; ++ai) _Pragma("unroll") for (int m = 0; m < 4; ++m) { \
        const int lr = u.pm * 256 + ai * 128 + wr * 64 + m * 16 + fr; (void)lr; \
        _Pragma("unroll") for (int bj = 0; bj < 2; ++bj) { \
            const int cb = bj * 128 + wc * 32 + 8 * fq; (void)cb; \
            float v[8]; { const pg8::f32x4 a0 = acc[ai][bj][m][0], a1 = acc[ai][bj][m][1]; v[0] = a0[0]; v[1] = a0[1]; v[2] = a0[2]; v[3] = a0[3]; v[4] = a1[0]; v[5] = a1[1]; v[6] = a1[2]; v[7] = a1[3]; }
#define EPI_LOOP_END } }
#define EPI_ROW(mm) (u.pm * 256 + ai * 128 + wr * 64 + (2 * mh + (mm)) * 16 + fr)
#define EPI_CB(bj) ((bj) * 128 + wc * 32 + 8 * fq)
#define EPI_V8(mm, bj) float v[8]; { const pg8::f32x4 a0 = acc[ai][bj][2 * mh + (mm)][0], a1 = acc[ai][bj][2 * mh + (mm)][1]; v[0] = a0[0]; v[1] = a0[1]; v[2] = a0[2]; v[3] = a0[3]; v[4] = a1[0]; v[5] = a1[1]; v[6] = a1[2]; v[7] = a1[3]; }

struct EpiProj {
    static constexpr bool PERM = true, AFTER_DRAIN = false;
    unsigned char* ws; float* out; const float* dt_bias; int g0;
    DI void operator()(const pg8::f32x4 (&acc)[2][2][4][2], const pg8::Unit& u, int wr, int wc, int fr_, int fq_) const {
        int fr = fr_, fq = fq_; asm volatile("" : "+v"(fr), "+v"(fq));
        const int pn = u.pn;
        if (pn < 8) {
            bf16_t* Z = (bf16_t*)(ws + OFF_Z);
            EPI_LOOP_BEGIN
#pragma unroll
                for (int e = 0; e < 8; ++e) v[e] = silu_f(v[e]);
                __builtin_nontemporal_store(pack8f(v), (u32x4*)(Z + (size_t)lr * 2048 + pn * 256 + cb));
            EPI_LOOP_END
        } else if (pn < 24) {
            bf16_t* X = (bf16_t*)(ws + OFF_XBC);
            EPI_LOOP_BEGIN
                const int col = (pn - 8) * 256 + cb;
                const u32x4 pk = pack8f(v);
                __builtin_nontemporal_store(pk, (u32x4*)(X + (size_t)lr * 4096 + col));
                int b, t, smp; row_info(g0 + lr, b, t, smp);
                if (!smp && (t & 63) >= 61) *(u32x4*)((bf16_t*)(ws + OFF_HALO) + ((size_t)(lr >> 6) * 3 + ((t & 63) - 61)) * 4096 + col) = pk;
                float* dst = nullptr;
                if (!smp) { if (t >= SEQ - 3) dst = out + OUT_CONV_P + (size_t)(b * 3 + (t - (SEQ - 3))) * 4096 + col; }
                else { if (t >= 29) dst = out + OUT_CONV_S + (size_t)(b * 3 + (t - 29)) * 4096 + col; }
                if (dst) { *(f32x4*)dst = (f32x4){v[0], v[1], v[2], v[3]}; *(f32x4*)(dst + 4) = (f32x4){v[4], v[5], v[6], v[7]}; }
            EPI_LOOP_END
        } else if (pn < 29) {
            const bool isq = pn < 28;
            bf16_t* D = isq ? (bf16_t*)(ws + OFF_Q) : (bf16_t*)(ws + OFF_K);
            const int ld = isq ? 1024 : 256, cbase = isq ? (pn - 24) * 256 : 0;
            const float* rope = (const float*)(ws + OFF_ROPE);
#pragma unroll
            for (int ai = 0; ai < 2; ++ai)
#pragma unroll
                for (int mh = 0; mh < 2; ++mh) {
                    f32x4 tb[2][4];
#pragma unroll
                    for (int mm = 0; mm < 2; ++mm) { int b, t, smp; row_info(g0 + EPI_ROW(mm), b, t, smp); const float* tr = rope + (size_t)(smp ? 4096 + t : t) * 16;
#pragma unroll
                        for (int k = 0; k < 4; ++k) tb[mm][k] = *(const f32x4*)(tr + 4 * k); }
#pragma unroll
                    for (int mm = 0; mm < 2; ++mm)
#pragma unroll
                        for (int bj = 0; bj < 2; ++bj) {
                            EPI_V8(mm, bj)
                            const int lr = EPI_ROW(mm), cb = EPI_CB(bj);
                            int b, t, smp; row_info(g0 + lr, b, t, smp);
                            if ((wc & 1) == 0) {
                                const f32x4 c0 = tb[mm][0], c1 = tb[mm][1], s0 = tb[mm][2], s1 = tb[mm][3];
                                const float cs[8] = {c0[0], c0[1], c0[2], c0[3], c1[0], c1[1], c1[2], c1[3]}, sn[8] = {s0[0], s0[1], s0[2], s0[3], s1[0], s1[1], s1[2], s1[3]};
#pragma unroll
                                for (int e = 0; e < 8; ++e) {
                                    const float other = __shfl_xor(v[e], 16);
                                    const float r0 = v[e] * cs[e] - other * sn[e], r1 = v[e] * cs[e] + other * sn[e];
                                    v[e] = fq == 0 ? r0 : (fq == 1 ? r1 : v[e]);
                                }
                            }
                            if (isq) {
#pragma unroll
                                for (int e = 0; e < 8; ++e) v[e] *= 0.125f;
                            } else {
                                float* dst = nullptr;
                                if (!smp) { if (t >= SEQ - 128) dst = out + OUT_K_P + (size_t)(b * 128 + (t - (SEQ - 128))) * 256 + cb; }
                                else dst = out + OUT_K_S + (size_t)(b * 128 + 96 + t) * 256 + cb;
                                if (dst) { *(f32x4*)dst = (f32x4){v[0], v[1], v[2], v[3]}; *(f32x4*)(dst + 4) = (f32x4){v[4], v[5], v[6], v[7]}; }
                            }
                            __builtin_nontemporal_store(pack8f(v), (u32x4*)(D + (size_t)lr * ld + cbase + cb));
                        }
                }
        } else if (pn == 29) {
            bf16_t* D = (bf16_t*)(ws + OFF_V);
            EPI_LOOP_BEGIN
                int b, t, smp; row_info(g0 + lr, b, t, smp);
                float* dst = nullptr;
                if (!smp) { if (t >= SEQ - 128) dst = out + OUT_V_P + (size_t)(b * 128 + (t - (SEQ - 128))) * 256 + cb; }
                else dst = out + OUT_V_S + (size_t)(b * 128 + 96 + t) * 256 + cb;
                if (dst) { *(f32x4*)dst = (f32x4){v[0], v[1], v[2], v[3]}; *(f32x4*)(dst + 4) = (f32x4){v[4], v[5], v[6], v[7]}; }
                __builtin_nontemporal_store(pack8f(v), (u32x4*)(D + (size_t)lr * 256 + cb));
            EPI_LOOP_END
        } else if (pn < 38) {
            bf16_t* D = (bf16_t*)(ws + OFF_GT);
            EPI_LOOP_BEGIN
#pragma unroll
                for (int e = 0; e < 8; ++e) v[e] = sigmoid_f(v[e]);
                __builtin_nontemporal_store(pack8f(v), (u32x4*)(D + (size_t)lr * 2048 + (pn - 30) * 256 + cb));
            EPI_LOOP_END
        } else {
            float* D = (float*)(ws + OFF_DT);
            EPI_LOOP_BEGIN
                if (cb < 32) {
#pragma unroll
                    for (int e = 0; e < 8; ++e) { const float xx = v[e] + dt_bias[cb + e]; v[e] = fmaxf(xx, 0.f) + __logf(1.f + __expf(-fabsf(xx))); }
                    float* dst = D + (size_t)lr * 32 + cb;
                    *(f32x4*)dst = (f32x4){v[0], v[1], v[2], v[3]}; *(f32x4*)(dst + 4) = (f32x4){v[4], v[5], v[6], v[7]};
                }
            EPI_LOOP_END
        }
    }
};

#define EPI_ROW4(mq) (u.pm * 256 + ai * 128 + wr * 64 + (mq) * 16 + fr)
#define EPI_V8M(mq, bj) float v[8]; { const pg8::f32x4 a0 = acc[ai][bj][mq][0], a1 = acc[ai][bj][mq][1]; v[0] = a0[0]; v[1] = a0[1]; v[2] = a0[2]; v[3] = a0[3]; v[4] = a1[0]; v[5] = a1[1]; v[6] = a1[2]; v[7] = a1[3]; }
struct EpiGateA {
    static constexpr bool PERM = true, AFTER_DRAIN = false;
    unsigned char* ws;
    DI void operator()(const pg8::f32x4 (&acc)[2][2][4][2], const pg8::Unit& u, int wr, int wc, int fr_, int fq_) const {
        int fr = fr_, fq = fq_; asm volatile("" : "+v"(fr), "+v"(fq));
        const bf16_t* GT = (const bf16_t*)(ws + OFF_GT); bf16_t* T1 = (bf16_t*)(ws + OFF_T1);
#pragma unroll
        for (int ai = 0; ai < 2; ++ai) {
            u32x4 gq[4][2];
#pragma unroll
            for (int mq = 0; mq < 4; ++mq)
#pragma unroll
                for (int bj = 0; bj < 2; ++bj) gq[mq][bj] = *(const u32x4*)(GT + (size_t)EPI_ROW4(mq) * 2048 + u.pn * 256 + EPI_CB(bj));
#pragma unroll
            for (int mq = 0; mq < 4; ++mq)
#pragma unroll
                for (int bj = 0; bj < 2; ++bj) {
                    EPI_V8M(mq, bj)
                    const u32x4 g = gq[mq][bj];
                    float o[8];
                    o[0] = v[0] * bflo(g.x); o[1] = v[1] * bfhi(g.x); o[2] = v[2] * bflo(g.y); o[3] = v[3] * bfhi(g.y);
                    o[4] = v[4] * bflo(g.z); o[5] = v[5] * bfhi(g.z); o[6] = v[6] * bflo(g.w); o[7] = v[7] * bfhi(g.w);
                    *(u32x4*)(T1 + (size_t)EPI_ROW4(mq) * 1024 + u.pn * 256 + EPI_CB(bj)) = pack8f(o);
                }
        }
    }
};
struct EpiGateB {
    static constexpr bool PERM = true, AFTER_DRAIN = false;
    unsigned char* ws;
    DI void operator()(const pg8::f32x4 (&acc)[2][2][4][2], const pg8::Unit& u, int wr, int wc, int fr_, int fq_) const {
        int fr = fr_, fq = fq_; asm volatile("" : "+v"(fr), "+v"(fq));
        const bf16_t* GT = (const bf16_t*)(ws + OFF_GT); const bf16_t* T1 = (const bf16_t*)(ws + OFF_T1); bf16_t* MR = (bf16_t*)(ws + OFF_MRG);
#pragma unroll
        for (int ai = 0; ai < 2; ++ai) {
            u32x4 gq[4][2], tq[4][2];
#pragma unroll
            for (int mq = 0; mq < 4; ++mq)
#pragma unroll
                for (int bj = 0; bj < 2; ++bj) { gq[mq][bj] = *(const u32x4*)(GT + (size_t)EPI_ROW4(mq) * 2048 + 1024 + u.pn * 256 + EPI_CB(bj));
                                                 tq[mq][bj] = *(const u32x4*)(T1 + (size_t)EPI_ROW4(mq) * 1024 + u.pn * 256 + EPI_CB(bj)); }
#pragma unroll
            for (int mq = 0; mq < 4; ++mq)
#pragma unroll
                for (int bj = 0; bj < 2; ++bj) {
                    EPI_V8M(mq, bj)
                    const u32x4 g = gq[mq][bj], t = tq[mq][bj];
                    float o[8];
                    o[0] = bflo(t.x) + v[0] * bflo(g.x); o[1] = bfhi(t.x) + v[1] * bfhi(g.x); o[2] = bflo(t.y) + v[2] * bflo(g.y); o[3] = bfhi(t.y) + v[3] * bfhi(g.y);
                    o[4] = bflo(t.z) + v[4] * bflo(g.z); o[5] = bfhi(t.z) + v[5] * bfhi(g.z); o[6] = bflo(t.w) + v[6] * bflo(g.w); o[7] = bfhi(t.w) + v[7] * bfhi(g.w);
                    *(u32x4*)(MR + (size_t)EPI_ROW4(mq) * 1024 + u.pn * 256 + EPI_CB(bj)) = pack8f(o);
                }
        }
    }
};
struct EpiB16 {
    static constexpr bool PERM = true, AFTER_DRAIN = false;
    bf16_t* D;
    DI void operator()(const pg8::f32x4 (&acc)[2][2][4][2], const pg8::Unit& u, int wr, int wc, int fr_, int fq_) const {
        int fr = fr_, fq = fq_; asm volatile("" : "+v"(fr), "+v"(fq));
        EPI_LOOP_BEGIN
            *(u32x4*)(D + (size_t)lr * 1024 + u.pn * 256 + cb) = pack8f(v);
        EPI_LOOP_END
    }
};
struct EpiG {
    static constexpr bool PERM = true, AFTER_DRAIN = false;
    unsigned char* ws; float* out; int g0;
    DI void operator()(const pg8::f32x4 (&acc)[2][2][4][2], const pg8::Unit& u, int wr, int wc, int fr_, int fq_) const {
        int fr = fr_, fq = fq_; asm volatile("" : "+v"(fr), "+v"(fq));
        bf16_t* GR = (bf16_t*)(ws + OFF_GR);
        EPI_LOOP_BEGIN
            const int col = u.pn * 256 + cb;
            *(u32x4*)(GR + (size_t)lr * DFF + col) = pack8f(v);
            int b, t, smp; row_info(g0 + lr, b, t, smp);
            float* dst = nullptr;
            if (!smp) { if (t >= SEQ - 2) dst = out + OUT_FFN_P + (size_t)(b * 2 + (t - (SEQ - 2))) * DFF + col; }
            else { if (t >= 30) dst = out + OUT_FFN_S + (size_t)(b * 2 + (t - 30)) * DFF + col; }
            if (dst) { *(f32x4*)dst = (f32x4){v[0], v[1], v[2], v[3]}; *(f32x4*)(dst + 4) = (f32x4){v[4], v[5], v[6], v[7]}; }
        EPI_LOOP_END
    }
};
template <int K> DI u32x4 dpp_ror4(u32x4 v) {
    u32x4 r;
    r.x = (unsigned)__builtin_amdgcn_update_dpp(0, (int)v.x, 0x120 + K, 0xF, 0xF, false); r.y = (unsigned)__builtin_amdgcn_update_dpp(0, (int)v.y, 0x120 + K, 0xF, 0xF, false);
    r.z = (unsigned)__builtin_amdgcn_update_dpp(0, (int)v.z, 0x120 + K, 0xF, 0xF, false); r.w = (unsigned)__builtin_amdgcn_update_dpp(0, (int)v.w, 0x120 + K, 0xF, 0xF, false);
    return r;
}
struct EpiU {
    static constexpr bool PERM = true, AFTER_DRAIN = false;
    unsigned char* ws; const float* cw; const float* cbias; const float* ffn_ctx; int g0;
    DI void operator()(const pg8::f32x4 (&acc)[2][2][4][2], const pg8::Unit& u, int wr, int wc, int fr_, int fq_) const {
        int fr = fr_, fq = fq_; asm volatile("" : "+v"(fr), "+v"(fq));
        const bf16_t* GR = (const bf16_t*)(ws + OFF_GR); bf16_t* ACT = (bf16_t*)(ws + OFF_ACT);
#pragma unroll
        for (int bj = 0; bj < 2; ++bj) {
            const int col = u.pn * 256 + EPI_CB(bj);
            const f32x4 cb0 = *(const f32x4*)(cbias + col), cb1 = *(const f32x4*)(cbias + col + 4);
            const f32x4 w00 = *(const f32x4*)(cw + col), w01 = *(const f32x4*)(cw + col + 4), w10 = *(const f32x4*)(cw + DFF + col), w11 = *(const f32x4*)(cw + DFF + col + 4), w20 = *(const f32x4*)(cw + 2 * DFF + col), w21 = *(const f32x4*)(cw + 2 * DFF + col + 4);
            const float cbv[8] = {cb0[0], cb0[1], cb0[2], cb0[3], cb1[0], cb1[1], cb1[2], cb1[3]};
            const float w0v[8] = {w00[0], w00[1], w00[2], w00[3], w01[0], w01[1], w01[2], w01[3]};
            const float w1v[8] = {w10[0], w10[1], w10[2], w10[3], w11[0], w11[1], w11[2], w11[3]};
            const float w2v[8] = {w20[0], w20[1], w20[2], w20[3], w21[0], w21[1], w21[2], w21[3]};
#pragma unroll
            for (int ai = 0; ai < 2; ++ai) {
                const int rbase = u.pm * 256 + ai * 128 + wr * 64;
                u32x4 X[5];
                { const int rp = rbase - 16 + fr; X[0] = *(const u32x4*)(GR + (size_t)(rp >= 0 ? rp : 0) * DFF + col); }
#pragma unroll
                for (int mq = 0; mq < 4; ++mq) X[1 + mq] = *(const u32x4*)(GR + (size_t)(rbase + mq * 16 + fr) * DFF + col);
#pragma unroll
                for (int mq = 0; mq < 4; ++mq) {
                    const u32x4 cur = X[1 + mq], prv = X[mq];
                    const u32x4 r1c = dpp_ror4<1>(cur), r1p = dpp_ror4<1>(prv), r2c = dpp_ror4<2>(cur), r2p = dpp_ror4<2>(prv);
                    u32x4 q1, q0;
                    q1.x = fr >= 1 ? r1c.x : r1p.x; q1.y = fr >= 1 ? r1c.y : r1p.y; q1.z = fr >= 1 ? r1c.z : r1p.z; q1.w = fr >= 1 ? r1c.w : r1p.w;
                    q0.x = fr >= 2 ? r2c.x : r2p.x; q0.y = fr >= 2 ? r2c.y : r2p.y; q0.z = fr >= 2 ? r2c.z : r2p.z; q0.w = fr >= 2 ? r2c.w : r2p.w;
                    float v[8]; { const pg8::f32x4 a0 = acc[ai][bj][mq][0], a1 = acc[ai][bj][mq][1]; v[0] = a0[0]; v[1] = a0[1]; v[2] = a0[2]; v[3] = a0[3]; v[4] = a1[0]; v[5] = a1[1]; v[6] = a1[2]; v[7] = a1[3]; }
                    const int lr = rbase + mq * 16 + fr;
                    int b, t, smp; row_info(g0 + lr, b, t, smp);
                    float x0[8], x1[8], x2[8];
                    x2[0] = bflo(cur.x); x2[1] = bfhi(cur.x); x2[2] = bflo(cur.y); x2[3] = bfhi(cur.y); x2[4] = bflo(cur.z); x2[5] = bfhi(cur.z); x2[6] = bflo(cur.w); x2[7] = bfhi(cur.w);
                    x1[0] = bflo(q1.x); x1[1] = bfhi(q1.x); x1[2] = bflo(q1.y); x1[3] = bfhi(q1.y); x1[4] = bflo(q1.z); x1[5] = bfhi(q1.z); x1[6] = bflo(q1.w); x1[7] = bfhi(q1.w);
                    x0[0] = bflo(q0.x); x0[1] = bfhi(q0.x); x0[2] = bflo(q0.y); x0[3] = bfhi(q0.y); x0[4] = bflo(q0.z); x0[5] = bfhi(q0.z); x0[6] = bflo(q0.w); x0[7] = bfhi(q0.w);
                    if (t < 2) {
                        if (smp) { const float* c0 = ffn_ctx + (size_t)(b * 2 + t) * DFF + col; const float* c1 = ffn_ctx + (size_t)(b * 2 + 1) * DFF + col;
#pragma unroll
                            for (int e = 0; e < 8; ++e) { x0[e] = c0[e]; if (t < 1) x1[e] = c1[e]; } }
                        else {
#pragma unroll
                            for (int e = 0; e < 8; ++e) { x0[e] = 0.f; if (t < 1) x1[e] = 0.f; } }
                    }
                    float o[8];
#pragma unroll
                    for (int e = 0; e < 8; ++e) { const float gg = cbv[e] + w0v[e] * x0[e] + w1v[e] * x1[e] + w2v[e] * x2[e]; o[e] = silu_f(gg) * v[e]; }
                    *(u32x4*)(ACT + (size_t)lr * DFF + col) = pack8f(o);
                }
            }
        }
    }
};

DI void transpose_item(const float* W, int K, int N, bf16_t* WT, int dst_row0, LAS float* scr, int k0, int n0, int lane) {
#pragma unroll 8
    for (int i = 0; i < 32; ++i) { const int kk = 2 * i + (lane >> 5); scr[kk * 33 + (lane & 31)] = W[(size_t)(k0 + kk) * N + n0 + (lane & 31)]; }
    asm volatile("s_waitcnt lgkmcnt(0)" ::: "memory");
    const int c = lane & 7;
#pragma unroll
    for (int j = 0; j < 4; ++j) { const int n = (lane >> 3) + 8 * j; const LAS float* s = scr + (8 * c) * 33 + n;
        u32x4 o; o.x = pk2(s[0 * 33], s[1 * 33]); o.y = pk2(s[2 * 33], s[3 * 33]); o.z = pk2(s[4 * 33], s[5 * 33]); o.w = pk2(s[6 * 33], s[7 * 33]);
        *(u32x4*)(WT + (size_t)(dst_row0 + n) * K + k0 + 8 * c) = o; }
    asm volatile("s_waitcnt lgkmcnt(0)" ::: "memory");
}

DI void phase0(const Params& P, LAS unsigned char* lds) {
    int tid_l = threadIdx.x; asm volatile("" : "+v"(tid_l));
    const int tid = tid_l, lane = tid & 63, wid = tid >> 6;
    const int gw = blockIdx.x * 8 + wid, NGW = gridDim.x * 8;
    LAS float* scr = (LAS float*)(lds + wid * 16384);
    constexpr int I_IN = 16 * 305, I_SSM = 32 * 32, I_ATT = 16 * 32, I_OUT = 16 * 32, I_FIN = 16 * 176, I_FOUT = 44 * 32;
    constexpr int NITEMS = I_IN + I_SSM + I_ATT + I_OUT + I_FIN + I_FOUT;
    for (int it = gw; it < NITEMS; it += NGW) {
        int r = it;
        if (r < I_IN) { const int kb = r / 305, nb = r % 305, n0 = 32 * nb; const int d0 = n0 < 6144 ? n0 : (n0 == 6144 ? 9728 : n0 - 32);
            transpose_item(P.w_in, 1024, 9760, (bf16_t*)(P.ws + OFF_WIN), d0, scr, 64 * kb, n0, lane); continue; } r -= I_IN;
        if (r < I_SSM) { transpose_item(P.w_ssm_out, 2048, 1024, (bf16_t*)(P.ws + OFF_WSSM), 32 * (r % 32), scr, 64 * (r / 32), 32 * (r % 32), lane); continue; } r -= I_SSM;
        if (r < I_ATT) { transpose_item(P.w_att_out, 1024, 1024, (bf16_t*)(P.ws + OFF_WATT), 32 * (r % 32), scr, 64 * (r / 32), 32 * (r % 32), lane); continue; } r -= I_ATT;
        if (r < I_OUT) { transpose_item(P.w_out, 1024, 1024, (bf16_t*)(P.ws + OFF_WOUT), 32 * (r % 32), scr, 64 * (r / 32), 32 * (r % 32), lane); continue; } r -= I_OUT;
        if (r < I_FIN) { transpose_item(P.w_ffn_in, 1024, 5632, (bf16_t*)(P.ws + OFF_WFIN), 32 * (r % 176), scr, 64 * (r / 176), 32 * (r % 176), lane); continue; } r -= I_FIN;
        transpose_item(P.w_ffn_out, 2816, 1024, (bf16_t*)(P.ws + OFF_WFOUT), 32 * (r % 32), scr, 64 * (r / 32), 32 * (r % 32), lane);
    }
    { const size_t n16 = (size_t)224 * 1024 * 2 / 16; u32x4* p = (u32x4*)(P.ws + OFF_WIN + (size_t)9760 * 1024 * 2);
      for (size_t i = (size_t)blockIdx.x * 512 + tid; i < n16; i += (size_t)gridDim.x * 512) p[i] = (u32x4){0u, 0u, 0u, 0u}; }
    { float* tab = (float*)(P.ws + OFF_ROPE);
      for (int i = blockIdx.x * 512 + tid; i < 4128 * 16; i += gridDim.x * 512) {
          const int row = i >> 4, e = i & 15, f = e & 7; const int pos = row < 4096 ? row : 2048 + (row - 4096);
          const float inv = powf(500000.0f, -(float)f / 8.0f); const float ang = (float)pos * inv;
          tab[i] = e < 8 ? (float)cos((double)ang) : (float)sin((double)ang); } }
    { const int n4 = 16 * 96 * 256 / 4;
      for (int i = blockIdx.x * 512 + tid; i < 2 * n4; i += gridDim.x * 512) {
          const int which = i >= n4, j = which ? i - n4 : i; const int b = j / (96 * 64), rem = j % (96 * 64);
          const f32x4 v = *((const f32x4*)((which ? P.cache_v : P.cache_k) + (size_t)(b * 128 + 32) * 256) + rem);
          *((f32x4*)(P.out + (which ? OUT_V_S : OUT_K_S) + (size_t)b * 128 * 256) + rem) = v; } }
    __syncthreads();
    LAS float* sc = (LAS float*)lds;
    for (int chunk = blockIdx.x; chunk < 192; chunk += gridDim.x) {
        for (int i = tid; i < 32 * 1024; i += 512) { const int r = i >> 10, k = i & 1023; const float c = r < 16 ? P.c_prompt[r * 1024 + k] : P.c_sample[(r - 16) * 1024 + k]; sc[i] = silu_f(c); }
        __syncthreads();
        const int col = tid & 31, ks = tid >> 5, c0 = chunk * 32;
        float a[32];
#pragma unroll
        for (int r = 0; r < 32; ++r) a[r] = 0.f;
        for (int k = ks * 64; k < ks * 64 + 64; k += 4) {
            const float w0 = P.w_ada[(size_t)k * 6144 + c0 + col], w1 = P.w_ada[(size_t)(k + 1) * 6144 + c0 + col], w2 = P.w_ada[(size_t)(k + 2) * 6144 + c0 + col], w3 = P.w_ada[(size_t)(k + 3) * 6144 + c0 + col];
#pragma unroll
            for (int r = 0; r < 32; ++r) { const f32x4 s = *(const LAS f32x4*)(sc + r * 1024 + k); a[r] += s[0] * w0 + s[1] * w1 + s[2] * w2 + s[3] * w3; }
        }
        __syncthreads();
#pragma unroll
        for (int r = 0; r < 32; ++r) sc[(ks * 32 + r) * 32 + col] = a[r];
        __syncthreads();
        for (int o = tid; o < 1024; o += 512) { const int r = o >> 5, cc = o & 31; float s = P.b_ada[c0 + cc];
#pragma unroll
            for (int q = 0; q < 16; ++q) s += sc[(q * 32 + r) * 32 + cc];
            ((float*)(P.ws + OFF_MOD))[r * 6144 + c0 + cc] = s; }
        __syncthreads();
    }
}

DI const float* xrow_ptr(const Params& P, int grow) { return grow < PROWS ? P.x_prompt + (size_t)grow * DM : P.x_sample + (size_t)(grow - PROWS) * DM; }
DI int seq_of(int grow) { return grow < PROWS ? (grow >> 12) : 16 + ((grow - PROWS) >> 5); }

DI void rowpass1(const Params& P, int g0, int rows) {
    int tid_l = threadIdx.x; asm volatile("" : "+v"(tid_l));
    const int lane = tid_l & 63, gw = blockIdx.x * 8 + (tid_l >> 6), NGW = gridDim.x * 8;
    const float* mod = (const float*)(P.ws + OFF_MOD); bf16_t* HN = (bf16_t*)(P.ws + OFF_HN);
    f32x4 v[4], nv[4];
    if (gw < rows) { const float* xr = xrow_ptr(P, g0 + gw);
#pragma unroll
        for (int j = 0; j < 4; ++j) v[j] = __builtin_nontemporal_load((const f32x4*)(xr + 4 * lane + 256 * j)); }
    for (int lr = gw; lr < rows; lr += NGW) {
        const int grow = g0 + lr; const float* md = mod + (size_t)seq_of(grow) * 6144;
        if (lr + NGW < rows) { const float* xn = xrow_ptr(P, grow + NGW);
#pragma unroll
            for (int j = 0; j < 4; ++j) nv[j] = __builtin_nontemporal_load((const f32x4*)(xn + 4 * lane + 256 * j)); }
        float ss = 0.f;
#pragma unroll
        for (int j = 0; j < 4; ++j) ss += (v[j][0] * v[j][0] + v[j][1] * v[j][1]) + (v[j][2] * v[j][2] + v[j][3] * v[j][3]);
        const float r = rsqrtf(wave_sum(ss) * (1.f / DM) + EPS);
#pragma unroll
        for (int j = 0; j < 4; ++j) { const int c = 4 * lane + 256 * j;
            const f32x4 w = *(const f32x4*)(P.norm_mix_pre + c), sh = *(const f32x4*)(md + c), scl = *(const f32x4*)(md + 1024 + c);
            const f32x4 h = (v[j] * r) * w * (scl + 1.f) + sh;
            u32x2 o; o.x = pk2(h[0], h[1]); o.y = pk2(h[2], h[3]); *(u32x2*)(HN + (size_t)lr * DM + c) = o; }
#pragma unroll
        for (int j = 0; j < 4; ++j) v[j] = nv[j];
    }
}
DI void rowpass2(const Params& P, int g0, int rows) {
    int tid_l = threadIdx.x; asm volatile("" : "+v"(tid_l));
    const int lane = tid_l & 63, gw = blockIdx.x * 8 + (tid_l >> 6), NGW = gridDim.x * 8;
    const float* mod = (const float*)(P.ws + OFF_MOD); bf16_t* HN = (bf16_t*)(P.ws + OFF_HN); const bf16_t* O = (const bf16_t*)(P.ws + OFF_O);
    u32x2 oq[4], noq[4]; f32x4 x[4], nx[4];
    if (gw < rows) { const float* xr = xrow_ptr(P, g0 + gw);
#pragma unroll
        for (int j = 0; j < 4; ++j) { oq[j] = __builtin_nontemporal_load((const u32x2*)(O + (size_t)gw * DM + 4 * lane + 256 * j)); x[j] = __builtin_nontemporal_load((const f32x4*)(xr + 4 * lane + 256 * j)); } }
    for (int lr = gw; lr < rows; lr += NGW) {
        const int grow = g0 + lr; const float* md = mod + (size_t)seq_of(grow) * 6144; float* yr = P.out + (size_t)grow * DM;
        if (lr + NGW < rows) { const float* xn = xrow_ptr(P, grow + NGW);
#pragma unroll
            for (int j = 0; j < 4; ++j) { noq[j] = __builtin_nontemporal_load((const u32x2*)(O + (size_t)(lr + NGW) * DM + 4 * lane + 256 * j)); nx[j] = __builtin_nontemporal_load((const f32x4*)(xn + 4 * lane + 256 * j)); } }
        f32x4 o[4]; float ss = 0.f;
#pragma unroll
        for (int j = 0; j < 4; ++j) { o[j] = (f32x4){bflo(oq[j].x), bfhi(oq[j].x), bflo(oq[j].y), bfhi(oq[j].y)}; ss += (o[j][0] * o[j][0] + o[j][1] * o[j][1]) + (o[j][2] * o[j][2] + o[j][3] * o[j][3]); }
        const float r1 = rsqrtf(wave_sum(ss) * (1.f / DM) + EPS);
        f32x4 x1[4]; float ss2 = 0.f;
#pragma unroll
        for (int j = 0; j < 4; ++j) { const int c = 4 * lane + 256 * j;
            const f32x4 w = *(const f32x4*)(P.norm_mix_post + c), g1 = *(const f32x4*)(md + 2048 + c);
            x1[j] = x[j] + g1 * ((o[j] * r1) * w);
            __builtin_nontemporal_store(x1[j], (f32x4*)(yr + c));
            ss2 += (x1[j][0] * x1[j][0] + x1[j][1] * x1[j][1]) + (x1[j][2] * x1[j][2] + x1[j][3] * x1[j][3]); }
        const float r2 = rsqrtf(wave_sum(ss2) * (1.f / DM) + EPS);
#pragma unroll
        for (int j = 0; j < 4; ++j) { const int c = 4 * lane + 256 * j;
            const f32x4 w = *(const f32x4*)(P.norm_ffn_pre + c), sh = *(const f32x4*)(md + 3072 + c), scl = *(const f32x4*)(md + 4096 + c);
            const f32x4 h = (x1[j] * r2) * w * (scl + 1.f) + sh;
            u32x2 q; q.x = pk2(h[0], h[1]); q.y = pk2(h[2], h[3]); *(u32x2*)(HN + (size_t)lr * DM + c) = q; }
#pragma unroll
        for (int j = 0; j < 4; ++j) { oq[j] = noq[j]; x[j] = nx[j]; }
    }
}
DI void rowpass3(const Params& P, int g0, int rows) {
    int tid_l = threadIdx.x; asm volatile("" : "+v"(tid_l));
    const int lane = tid_l & 63, gw = blockIdx.x * 8 + (tid_l >> 6), NGW = gridDim.x * 8;
    const float* mod = (const float*)(P.ws + OFF_MOD); const bf16_t* F = (const bf16_t*)(P.ws + OFF_F);
    u32x2 fq[4], nfq[4]; f32x4 y[4], ny[4];
    if (gw < rows) { const float* yr = P.out + (size_t)(g0 + gw) * DM;
#pragma unroll
        for (int j = 0; j < 4; ++j) { fq[j] = __builtin_nontemporal_load((const u32x2*)(F + (size_t)gw * DM + 4 * lane + 256 * j)); y[j] = __builtin_nontemporal_load((const f32x4*)(yr + 4 * lane + 256 * j)); } }
    for (int lr = gw; lr < rows; lr += NGW) {
        const int grow = g0 + lr; const float* md = mod + (size_t)seq_of(grow) * 6144; float* yr = P.out + (size_t)grow * DM;
        if (lr + NGW < rows) { const float* yn = P.out + (size_t)(grow + NGW) * DM;
#pragma unroll
            for (int j = 0; j < 4; ++j) { nfq[j] = __builtin_nontemporal_load((const u32x2*)(F + (size_t)(lr + NGW) * DM + 4 * lane + 256 * j)); ny[j] = __builtin_nontemporal_load((const f32x4*)(yn + 4 * lane + 256 * j)); } }
        f32x4 f[4]; float ss = 0.f;
#pragma unroll
        for (int j = 0; j < 4; ++j) { f[j] = (f32x4){bflo(fq[j].x), bfhi(fq[j].x), bflo(fq[j].y), bfhi(fq[j].y)}; ss += (f[j][0] * f[j][0] + f[j][1] * f[j][1]) + (f[j][2] * f[j][2] + f[j][3] * f[j][3]); }
        const float r = rsqrtf(wave_sum(ss) * (1.f / DM) + EPS);
#pragma unroll
        for (int j = 0; j < 4; ++j) { const int c = 4 * lane + 256 * j;
            const f32x4 w = *(const f32x4*)(P.norm_ffn_post + c), g2 = *(const f32x4*)(md + 5120 + c);
            __builtin_nontemporal_store(y[j] + g2 * ((f[j] * r) * w), (f32x4*)(yr + c)); }
#pragma unroll
        for (int j = 0; j < 4; ++j) { fq[j] = nfq[j]; y[j] = ny[j]; }
    }
}

DI void conv_pass(const Params& P, int gi, int cu, int ncu) {
    int tid_l = threadIdx.x; asm volatile("" : "+v"(tid_l));
    const int col = tid_l * 8;
    bf16_t* X = (bf16_t*)(P.ws + OFF_XBC); const bf16_t* HALO = (const bf16_t*)(P.ws + OFF_HALO);
    float cw[4][8], cb[8];
#pragma unroll
    for (int j = 0; j < 4; ++j) { const f32x4 a = *(const f32x4*)(P.ssm_conv_w + j * 4096 + col), b2 = *(const f32x4*)(P.ssm_conv_w + j * 4096 + col + 4);
        cw[j][0] = a[0]; cw[j][1] = a[1]; cw[j][2] = a[2]; cw[j][3] = a[3]; cw[j][4] = b2[0]; cw[j][5] = b2[1]; cw[j][6] = b2[2]; cw[j][7] = b2[3]; }
    { const f32x4 a = *(const f32x4*)(P.ssm_conv_b + col), b2 = *(const f32x4*)(P.ssm_conv_b + col + 4);
      cb[0] = a[0]; cb[1] = a[1]; cb[2] = a[2]; cb[3] = a[3]; cb[4] = b2[0]; cb[5] = b2[1]; cb[6] = b2[2]; cb[7] = b2[3]; }
    const int nunits = 512 + (gi ? 16 : 0);
    for (int u = cu; u < nunits; u += ncu) {
        const bool smp = u >= 512;
        const int lr0 = smp ? 32768 + (u - 512) * 32 : u * 64, nb8 = smp ? 4 : 8;
        float p[3][8];
        if (smp) {
#pragma unroll
            for (int i = 0; i < 3; ++i) { const float* c = P.state_conv + (size_t)((u - 512) * 3 + i) * 4096 + col; const f32x4 a = *(const f32x4*)c, b2 = *(const f32x4*)(c + 4);
                p[i][0] = a[0]; p[i][1] = a[1]; p[i][2] = a[2]; p[i][3] = a[3]; p[i][4] = b2[0]; p[i][5] = b2[1]; p[i][6] = b2[2]; p[i][7] = b2[3]; }
        } else if ((lr0 & 4095) == 0) {
#pragma unroll
            for (int i = 0; i < 3; ++i)
#pragma unroll
                for (int e = 0; e < 8; ++e) p[i][e] = 0.f;
        } else {
#pragma unroll
            for (int i = 0; i < 3; ++i) { const u32x4 q = *(const u32x4*)(HALO + ((size_t)(u - 1) * 3 + i) * 4096 + col);
                p[i][0] = bflo(q.x); p[i][1] = bfhi(q.x); p[i][2] = bflo(q.y); p[i][3] = bfhi(q.y); p[i][4] = bflo(q.z); p[i][5] = bfhi(q.z); p[i][6] = bflo(q.w); p[i][7] = bfhi(q.w); }
        }
        bf16_t* xp = X + (size_t)lr0 * 4096 + col;
        for (int l8 = 0; l8 < nb8; ++l8) {
            u32x4 q[8];
#pragma unroll
            for (int e = 0; e < 8; ++e) q[e] = __builtin_nontemporal_load((const u32x4*)(xp + (size_t)(l8 * 8 + e) * 4096));
#pragma unroll
            for (int e = 0; e < 8; ++e) {
                float cur[8] = {bflo(q[e].x), bfhi(q[e].x), bflo(q[e].y), bfhi(q[e].y), bflo(q[e].z), bfhi(q[e].z), bflo(q[e].w), bfhi(q[e].w)};
                float o[8];
#pragma unroll
                for (int k = 0; k < 8; ++k) { o[k] = silu_f(cb[k] + cw[0][k] * p[0][k] + cw[1][k] * p[1][k] + cw[2][k] * p[2][k] + cw[3][k] * cur[k]); p[0][k] = p[1][k]; p[1][k] = p[2][k]; p[2][k] = cur[k]; }
                *(u32x4*)(xp + (size_t)(l8 * 8 + e) * 4096) = pack8f(o);
            }
        }
    }
}

constexpr int SL_XT = 0, SL_BM = 36864, SL_CM = 54272, SL_BMT = 71680, SL_YT = 90112, SL_ARR = 122880;
template <int MODE>
DI void ssd_unit(const Params& P, LAS unsigned char* lds, int g0, int b, int g, int sample, int seg) {
    int tid_l = threadIdx.x; asm volatile("" : "+v"(tid_l));
    const int tid = tid_l, lane = tid & 63, wid = __builtin_amdgcn_readfirstlane(tid >> 6);
    const int lrow0 = sample ? (PROWS - g0) + b * 32 : (b * SEQ - g0);
    const int ck0 = sample ? 0 : seg * 16, nchunks = sample ? 1 : ck0 + 16, ntok = sample ? 32 : 64;
    const bf16_t* XBC = (const bf16_t*)(P.ws + OFF_XBC); const bf16_t* Zb = (const bf16_t*)(P.ws + OFF_Z); const float* DT = (const float*)(P.ws + OFF_DT); bf16_t* YS = (bf16_t*)(P.ws + OFF_YS);
    LAS unsigned char* XT = lds + SL_XT; LAS unsigned char* BM = lds + SL_BM; LAS unsigned char* CM = lds + SL_CM; LAS unsigned char* BMT = lds + SL_BMT; LAS unsigned char* YT = lds + SL_YT;
    LAS float* ARR = (LAS float*)(lds + SL_ARR);
    const int cp = tid & 255, th = __builtin_amdgcn_readfirstlane(tid >> 8), c0 = 2 * cp;
    const int colc = c0 < 256 ? g * 256 + c0 : (c0 < 384 ? 2048 + g * 128 + (c0 - 256) : 3072 + g * 128 + (c0 - 384));
    const float ldmask = (sample && th == 1) ? 0.f : 1.f;
    unsigned raw[32];
    const unsigned colc2 = (unsigned)colc * 2u;
#define SSD_ISSUE(CK) do { const char* ub_ = (const char*)XBC + (size_t)(lrow0 + (CK) * 64 + 32 * th) * 8192;     \
        _Pragma("unroll") for (int i = 0; i < 32; ++i) raw[i] = *(const unsigned*)(ub_ + (size_t)i * 8192 + colc2); } while (0)
    const int r = wid >> 1, hp = wid & 1, c31_0 = lane & 31, h_0 = lane >> 5;
    const float Dr = P.ssm_d[g * 4 + r];
    const LAS float* dtl = ARR + r * 64; const LAS float* acsr = ARR + 256 + r * 64; const LAS float* eacsr = ARR + 512 + r * 64; const LAS float* wscr = ARR + 768 + r * 64;
    float* stout = P.out + (sample ? OUT_SSM_S : OUT_SSM_P) + ((size_t)(b * 32 + g * 4 + r) * 64 + 32 * hp + c31_0) * 128;
    f32x16 HT[4];
#pragma unroll
    for (int nb = 0; nb < 4; ++nb)
#pragma unroll
        for (int i = 0; i < 16; ++i) HT[nb][i] = 0.f;
    if (sample) {
        const float* si = P.state_ssm + ((size_t)(b * 32 + g * 4 + r) * 64 + 32 * hp + c31_0) * 128;
#pragma unroll
        for (int nb = 0; nb < 4; ++nb)
#pragma unroll
            for (int i4 = 0; i4 < 4; ++i4) { const f32x4 q = *(const f32x4*)(si + 32 * nb + 8 * i4 + 4 * h_0); HT[nb][4 * i4] = q[0]; HT[nb][4 * i4 + 1] = q[1]; HT[nb][4 * i4 + 2] = q[2]; HT[nb][4 * i4 + 3] = q[3]; }
    }
    const size_t sidx = (size_t)(((b & 7) * 8 + g) * 3) * 4 + r;
    if (MODE == 1 && !sample && seg > 0) {
        const float* Fb = (const float*)(P.ws + OFF_SSF) + sidx * 8192 + (size_t)(32 * hp + c31_0) * 128; const float* Db = (const float*)(P.ws + OFF_SSDK) + sidx;
#pragma unroll
        for (int s = 0; s < 3; ++s) if (s < seg) {
            const float d = s == 0 ? 0.f : Db[4 * s];
#pragma unroll
            for (int nb = 0; nb < 4; ++nb)
#pragma unroll
                for (int i4 = 0; i4 < 4; ++i4) { const f32x4 q = *(const f32x4*)(Fb + (size_t)s * 4 * 8192 + 32 * nb + 8 * i4 + 4 * h_0);
                    HT[nb][4 * i4] = HT[nb][4 * i4] * d + q[0]; HT[nb][4 * i4 + 1] = HT[nb][4 * i4 + 1] * d + q[1]; HT[nb][4 * i4 + 2] = HT[nb][4 * i4 + 2] * d + q[2]; HT[nb][4 * i4 + 3] = HT[nb][4 * i4 + 3] * d + q[3]; }
        }
    }
    float ssum = 0.f;
    if (MODE == 1 || c0 < 384) SSD_ISSUE(ck0);
    float dtv_n = (wid < 4 && lane < ntok) ? DT[(size_t)(lrow0 + ck0 * 64 + lane) * 32 + g * 4 + wid] : 0.f;
    for (int ck = ck0; ck < nchunks; ++ck) {
        const int cb0 = lrow0 + ck * 64;
        const int boff = (MODE == 0) ? (ck & 1) * 59392 : 0;
        LAS unsigned char* XT = (MODE == 0) ? lds + boff : lds + SL_XT; LAS unsigned char* BMT = (MODE == 0) ? lds + boff + 36864 : lds + SL_BMT;
        LAS float* ARR = (MODE == 0) ? (LAS float*)(lds + boff + 55296) : (LAS float*)(lds + SL_ARR);
        const LAS float* dtl = ARR + r * 64; const LAS float* acsr = ARR + 256 + r * 64; const LAS float* eacsr = ARR + 512 + r * 64; const LAS float* wscr = ARR + 768 + r * 64;
        (void)dtl; (void)acsr;
        int c31 = c31_0, h = h_0, tidv = tid, cpv = cp; asm volatile("" : "+v"(c31), "+v"(h), "+v"(tidv), "+v"(cpv));
        if (wid < 4) {
            const int hidx = g * 4 + wid;
            const float dtv = dtv_n;
            const float Ar = -__expf(P.ssm_a_log[hidx]);
            float acs = dtv * Ar;
#pragma unroll
            for (int o = 1; o < 64; o <<= 1) { const float t = __shfl_up(acs, o); if (lane >= o) acs += t; }
            const float last = __shfl(acs, 63);
            ARR[wid * 64 + lane] = dtv; ARR[256 + wid * 64 + lane] = acs; ARR[512 + wid * 64 + lane] = __expf(acs); ARR[768 + wid * 64 + lane] = dtv * __expf(last - acs);
        }
        {
            const int c0v = 2 * cpv;
            unsigned pa[16], pb[16];
            unsigned pab[32];
            const unsigned msk = ldmask != 0.f ? 0xffffffffu : 0u;
#pragma unroll
            for (int e = 0; e < 32; ++e) pab[e] = raw[e] & msk;
#pragma unroll
            for (int e = 0; e < 32; e += 2) { pa[e >> 1] = __builtin_amdgcn_perm(pab[e + 1], pab[e], 0x05040100u); pb[e >> 1] = __builtin_amdgcn_perm(pab[e + 1], pab[e], 0x07060302u); }
            if (c0v < 256) {
#pragma unroll
                for (int k = 0; k < 4; ++k) { *(LAS u32x4*)(XT + c0v * 144 + th * 64 + k * 16) = (u32x4){pa[4 * k], pa[4 * k + 1], pa[4 * k + 2], pa[4 * k + 3]};
                                              *(LAS u32x4*)(XT + (c0v + 1) * 144 + th * 64 + k * 16) = (u32x4){pb[4 * k], pb[4 * k + 1], pb[4 * k + 2], pb[4 * k + 3]}; }
            } else if (c0v < 384) {
                const int n = c0v - 256;
#pragma unroll
                for (int k = 0; k < 4; ++k) { *(LAS u32x4*)(BMT + n * 144 + th * 64 + k * 16) = (u32x4){pa[4 * k], pa[4 * k + 1], pa[4 * k + 2], pa[4 * k + 3]};
                                              *(LAS u32x4*)(BMT + (n + 1) * 144 + th * 64 + k * 16) = (u32x4){pb[4 * k], pb[4 * k + 1], pb[4 * k + 2], pb[4 * k + 3]}; }
                if (MODE == 1) {
#pragma unroll
                for (int e = 0; e < 32; ++e) *(LAS unsigned*)(BM + (32 * th + e) * 272 + n * 2) = pab[e]; }
            } else if (MODE == 1) {
                const int n = c0v - 384;
#pragma unroll
                for (int e = 0; e < 32; ++e) *(LAS unsigned*)(CM + (32 * th + e) * 272 + n * 2) = pab[e];
            }
        }
        __syncthreads();
        const int nl = tidv >> 3, seg8 = tidv & 7; u32x4 zq[4];
        if (MODE == 1) {
        f32x16 Y[2];
#pragma unroll
        for (int lb = 0; lb < 2; ++lb) {
#pragma unroll
            for (int i = 0; i < 16; ++i) Y[lb][i] = 0.f;
            const int l = 32 * lb + c31; const float acs_l = acsr[l];
#pragma unroll
            for (int sb = 0; sb <= lb; ++sb) {
                f32x16 G;
#pragma unroll
                for (int i = 0; i < 16; ++i) G[i] = 0.f;
#pragma unroll
                for (int kh2 = 0; kh2 < 4; ++kh2) {
                    bf16x8 fa[2], fb[2];
#pragma unroll
                    for (int q = 0; q < 2; ++q) { const int ks = 2 * kh2 + q;
                        fa[q] = *(const LAS bf16x8*)(BM + (32 * sb + c31) * 272 + ks * 32 + h * 16);
                        fb[q] = *(const LAS bf16x8*)(CM + (32 * lb + c31) * 272 + ks * 32 + h * 16); }
#pragma unroll
                    for (int q = 0; q < 2; ++q) G = MFMA32(fa[q], fb[q], G);
                }
                bf16x8 Bx[2];
#pragma unroll
                for (int st = 0; st < 2; ++st) Bx[st] = ld2x8(XT + (r * 64 + 32 * hp + c31) * 144 + (32 * sb + 16 * st + 4 * h) * 2);
#pragma unroll
                for (int i4 = 0; i4 < 4; ++i4) {
                    const int s0 = 32 * sb + 8 * i4 + 4 * h;
                    const f32x4 as4 = *(const LAS f32x4*)(acsr + s0), ds4 = *(const LAS f32x4*)(dtl + s0);
#pragma unroll
                    for (int j = 0; j < 4; ++j) { const int s = s0 + j; const float arg = fminf(acs_l - as4[j], 0.f);
                        float val = G[4 * i4 + j] * __expf(arg) * ds4[j]; val = s <= l ? val : 0.f; if (s == l) val += Dr; G[4 * i4 + j] = val; }
                }
#pragma unroll
                for (int st = 0; st < 2; ++st) { const bf16x8 A = PACK8(G, st); Y[lb] = MFMA32(A, Bx[st], Y[lb]); }
            }
        }
        if (nl < ntok) {
#pragma unroll
            for (int k = 0; k < 4; ++k) zq[k] = *(const u32x4*)(Zb + (size_t)(cb0 + nl) * 2048 + g * 256 + seg8 * 32 + 8 * k);
        } else {
#pragma unroll
            for (int k = 0; k < 4; ++k) zq[k] = (u32x4){0u, 0u, 0u, 0u};
        }
        __builtin_amdgcn_sched_barrier(0);
        {
            f32x16 T[2];
#pragma unroll
            for (int lb = 0; lb < 2; ++lb)
#pragma unroll
                for (int i = 0; i < 16; ++i) T[lb][i] = 0.f;
#pragma unroll
            for (int nb = 0; nb < 4; ++nb) {
                bf16x8 A[2][2];
#pragma unroll
                for (int st = 0; st < 2; ++st)
#pragma unroll
                    for (int lb = 0; lb < 2; ++lb) A[st][lb] = ld2x8(CM + (32 * lb + c31) * 272 + (32 * nb + 16 * st + 4 * h) * 2);
#pragma unroll
                for (int st = 0; st < 2; ++st) {
                    const bf16x8 HF = PACK8(HT[nb], st);
#pragma unroll
                    for (int lb = 0; lb < 2; ++lb) T[lb] = MFMA32(A[st][lb], HF, T[lb]);
                }
            }
#pragma unroll
            for (int lb = 0; lb < 2; ++lb)
#pragma unroll
                for (int i4 = 0; i4 < 4; ++i4) { const f32x4 e4 = *(const LAS f32x4*)(eacsr + 32 * lb + 8 * i4 + 4 * h);
#pragma unroll
                    for (int j = 0; j < 4; ++j) Y[lb][4 * i4 + j] += e4[j] * T[lb][4 * i4 + j]; }
        }
#pragma unroll
        for (int lb = 0; lb < 2; ++lb)
#pragma unroll
            for (int i4 = 0; i4 < 4; ++i4)
#pragma unroll
                for (int j = 0; j < 4; ++j) {
                    const int lc = 32 * lb + 8 * i4 + j, ch = r * 64 + 32 * hp + c31;
                    *(LAS bf16_t*)(YT + (4 * h * 512 + ch * 2) + lc * 512) = f2bf(Y[lb][4 * i4 + j]);
                }
        }
        if (ck + 1 < nchunks) {
            if (MODE == 1 || c0 < 384) SSD_ISSUE(ck + 1);
            if (wid < 4 && lane < ntok) dtv_n = DT[(size_t)(cb0 + 64 + lane) * 32 + g * 4 + wid];
        }
        __builtin_amdgcn_sched_barrier(0);
        {
            const float ea = eacsr[63]; ssum += acsr[63];
#pragma unroll
            for (int nb = 0; nb < 4; ++nb)
#pragma unroll
                for (int i = 0; i < 16; ++i) HT[nb][i] *= ea;
#pragma unroll
            for (int st = 0; st < 4; ++st) {
                const u32x4 rawx = *(const LAS u32x4*)(XT + (r * 64 + 32 * hp + c31) * 144 + st * 32 + h * 16);
                const f32x4 w0 = *(const LAS f32x4*)(wscr + 16 * st + 8 * h), w1 = *(const LAS f32x4*)(wscr + 16 * st + 8 * h + 4);
                bf16x8 A[4];
#pragma unroll
                for (int nb = 0; nb < 4; ++nb) A[nb] = *(const LAS bf16x8*)(BMT + (32 * nb + c31) * 144 + st * 32 + h * 16);
                u32x4 sc; sc.x = pk2(bflo(rawx.x) * w0[0], bfhi(rawx.x) * w0[1]); sc.y = pk2(bflo(rawx.y) * w0[2], bfhi(rawx.y) * w0[3]);
                sc.z = pk2(bflo(rawx.z) * w1[0], bfhi(rawx.z) * w1[1]); sc.w = pk2(bflo(rawx.w) * w1[2], bfhi(rawx.w) * w1[3]);
                const bf16x8 Bf = __builtin_bit_cast(bf16x8, sc);
#pragma unroll
                for (int nb = 0; nb < 4; ++nb) HT[nb] = MFMA32(A[nb], Bf, HT[nb]);
            }
        }
        if (MODE == 1) __syncthreads();
        if (MODE == 1)
        {
            float v[32]; float ss = 0.f;
#pragma unroll
            for (int k = 0; k < 4; ++k) { const u32x4 q = *(const LAS u32x4*)(YT + nl * 512 + seg8 * 64 + k * 16);
                v[8 * k] = bflo(q.x) * bflo(zq[k].x); v[8 * k + 1] = bfhi(q.x) * bfhi(zq[k].x); v[8 * k + 2] = bflo(q.y) * bflo(zq[k].y); v[8 * k + 3] = bfhi(q.y) * bfhi(zq[k].y);
                v[8 * k + 4] = bflo(q.z) * bflo(zq[k].z); v[8 * k + 5] = bfhi(q.z) * bfhi(zq[k].z); v[8 * k + 6] = bflo(q.w) * bflo(zq[k].w); v[8 * k + 7] = bfhi(q.w) * bfhi(zq[k].w); }
#pragma unroll
            for (int e = 0; e < 32; ++e) ss += v[e] * v[e];
            ss += __shfl_xor(ss, 1); ss += __shfl_xor(ss, 2); ss += __shfl_xor(ss, 4);
            const float rstd = rsqrtf(ss * (1.f / 256.f) + EPS);
            if (nl < ntok) {
                const float* nw = P.ssm_norm + g * 256 + seg8 * 32; bf16_t* dst = YS + (size_t)(cb0 + nl) * 2048 + g * 256 + seg8 * 32;
#pragma unroll
                for (int k = 0; k < 4; ++k) { float o[8];
#pragma unroll
                    for (int e = 0; e < 8; ++e) o[e] = v[8 * k + e] * rstd * nw[8 * k + e];
                    *(u32x4*)(dst + 8 * k) = pack8f(o); }
            }
        }
    }
#undef SSD_ISSUE
    if (MODE == 0) {
        float* Fo = (float*)(P.ws + OFF_SSF) + (sidx + 4 * seg) * 8192 + (size_t)(32 * hp + c31_0) * 128;
#pragma unroll
        for (int nb = 0; nb < 4; ++nb)
#pragma unroll
            for (int i4 = 0; i4 < 4; ++i4) *(f32x4*)(Fo + 32 * nb + 8 * i4 + 4 * h_0) = (f32x4){HT[nb][4 * i4], HT[nb][4 * i4 + 1], HT[nb][4 * i4 + 2], HT[nb][4 * i4 + 3]};
        if (hp == 0 && lane == 0) ((float*)(P.ws + OFF_SSDK))[sidx + 4 * seg] = __expf(ssum);
    } else if (sample || seg == 3) {
#pragma unroll
        for (int nb = 0; nb < 4; ++nb)
#pragma unroll
            for (int i4 = 0; i4 < 4; ++i4) *(f32x4*)(stout + 32 * nb + 8 * i4 + 4 * h_0) = (f32x4){HT[nb][4 * i4], HT[nb][4 * i4 + 1], HT[nb][4 * i4 + 2], HT[nb][4 * i4 + 3]};
    }
    __syncthreads();
}

constexpr int AL_K = 0, AL_V = 27648, AL_O = AL_V + 64 * 392;
DI void attn_range(const Params& P, LAS unsigned char* lds, int g0, int gi, int u0, int u1, int ustep) {
    if (u0 >= u1) return;
    int tid_l = threadIdx.x; asm volatile("" : "+v"(tid_l));
    const int tid = tid_l, lane = tid & 63, wid = __builtin_amdgcn_readfirstlane(tid >> 6), c31 = lane & 31, h = lane >> 5;
    const bf16_t* Qb = (const bf16_t*)(P.ws + OFF_Q); const bf16_t* Kb = (const bf16_t*)(P.ws + OFF_K); const bf16_t* Vb = (const bf16_t*)(P.ws + OFF_V);
    bf16_t* YA = (bf16_t*)(P.ws + OFF_Q);
    LAS unsigned char* KT = lds + AL_K; LAS unsigned char* VT = lds + AL_V; LAS unsigned char* OS = lds + AL_O + wid * 4096;
    u32x4 kk[3], vv[3]; bf16x8 Bn[4];
#define ATT_ISSUE(UN) do { const int b_ = gi * 8 + ((UN) >> 8), c_ = ((UN) >> 2) & 63, kh_ = (UN) & 3; const int cs_ = c_ >= 2 ? c_ - 2 : 0, nk_ = (c_ - cs_ + 1) * 64; \
        const int kr_ = b_ * SEQ - g0 + cs_ * 64, qr_ = b_ * SEQ - g0 + c_ * 64; \
        _Pragma("unroll") for (int it = 0; it < 3; ++it) { const int idx = tid + it * 512, key = idx >> 3, d8 = (idx & 7) * 8, keyc = key < nk_ ? key : nk_ - 1; \
            kk[it] = *(const u32x4*)(Kb + (size_t)(kr_ + keyc) * 256 + kh_ * 64 + d8); vv[it] = *(const u32x4*)(Vb + (size_t)(kr_ + keyc) * 256 + kh_ * 64 + d8); } \
        { const int hq_ = kh_ * 4 + (wid >> 1), lrq_ = qr_ + (wid & 1) * 32 + c31; \
          _Pragma("unroll") for (int st = 0; st < 4; ++st) Bn[st] = *(const bf16x8*)(Qb + (size_t)lrq_ * 1024 + hq_ * 64 + 16 * st + 8 * h); } } while (0)
    if (u0 < 2048) ATT_ISSUE(u0);
    for (int u = u0; u < u1; u += ustep) {
        const int sample = u >= 2048, uu = sample ? u - 2048 : u;
        const int b = sample ? (uu >> 2) : gi * 8 + (uu >> 8), c = sample ? 0 : ((uu >> 2) & 63), kh = uu & 3;
        int nkeys, krow0 = 0, qrow0;
        if (!sample) { const int cs = c >= 2 ? c - 2 : 0; nkeys = (c - cs + 1) * 64; krow0 = b * SEQ - g0 + cs * 64; qrow0 = b * SEQ - g0 + c * 64; }
        else { nkeys = 160; qrow0 = PROWS - g0 + b * 32; }
        const int nkb = nkeys >> 5;
        const int rq = sample ? (wid & 3) : (wid >> 1), qh = sample ? 0 : (wid & 1);
        const int hq = kh * 4 + rq, lrq = qrow0 + qh * 32 + c31;
        bf16x8 Bq[4];
        if (!sample) {
#pragma unroll
            for (int it = 0; it < 3; ++it) { const int idx = tid + it * 512, key = idx >> 3, d8 = (idx & 7) * 8;
                if (key < nkeys) {
                    *(LAS u32x4*)(KT + key * 144 + d8 * 2) = kk[it];
#pragma unroll
                    for (int e = 0; e < 8; ++e) *(LAS bf16_t*)(VT + (d8 + e) * 392 + key * 2) = (bf16_t)((vv[it][e >> 1] >> (16 * (e & 1))) & 0xffffu);
                } }
#pragma unroll
            for (int st = 0; st < 4; ++st) Bq[st] = Bn[st];
        } else {
#pragma unroll
            for (int st = 0; st < 4; ++st) Bq[st] = *(const bf16x8*)(Qb + (size_t)lrq * 1024 + hq * 64 + 16 * st + 8 * h);
            for (int idx = tid; idx < nkeys * 8; idx += 512) {
                const int key = idx >> 3, d8 = (idx & 7) * 8;
                u32x4 k1, v1;
                if (key < 128) {
                    const float* ck = P.cache_k + ((size_t)(b * 128 + key) * 4 + kh) * 64 + d8; const float* cv = P.cache_v + ((size_t)(b * 128 + key) * 4 + kh) * 64 + d8;
                    const f32x4 a0 = *(const f32x4*)ck, a1 = *(const f32x4*)(ck + 4), b0 = *(const f32x4*)cv, b1 = *(const f32x4*)(cv + 4);
                    k1.x = pk2(a0[0], a0[1]); k1.y = pk2(a0[2], a0[3]); k1.z = pk2(a1[0], a1[1]); k1.w = pk2(a1[2], a1[3]);
                    v1.x = pk2(b0[0], b0[1]); v1.y = pk2(b0[2], b0[3]); v1.z = pk2(b1[0], b1[1]); v1.w = pk2(b1[2], b1[3]);
                } else {
                    const int lrk = qrow0 + (key - 128);
                    k1 = *(const u32x4*)(Kb + (size_t)lrk * 256 + kh * 64 + d8); v1 = *(const u32x4*)(Vb + (size_t)lrk * 256 + kh * 64 + d8);
                }
                *(LAS u32x4*)(KT + key * 144 + d8 * 2) = k1;
#pragma unroll
                for (int e = 0; e < 8; ++e) *(LAS bf16_t*)(VT + (d8 + e) * 392 + key * 2) = (bf16_t)((v1[e >> 1] >> (16 * (e & 1))) & 0xffffu);
            }
        }
        __syncthreads();
        { const int un = u + ustep; if (un < u1 && un < 2048) ATT_ISSUE(un); }
        const bool active = sample ? (wid < 4) : true;
        if (active) {
            f32x16 S[6];
#pragma unroll
            for (int kb = 0; kb < 6; ++kb) {
#pragma unroll
                for (int i = 0; i < 16; ++i) S[kb][i] = 0.f;
                if (kb < nkb) {
#pragma unroll
                    for (int st = 0; st < 4; ++st) { const bf16x8 A = *(const LAS bf16x8*)(KT + (32 * kb + c31) * 144 + st * 32 + h * 16); S[kb] = MFMA32(A, Bq[st], S[kb]); }
                }
            }
            const float sink = P.attn_sinks[hq];
            float m = sink;
#pragma unroll
            for (int kb = 0; kb < 6; ++kb) if (kb < nkb) {
#pragma unroll
                for (int i = 0; i < 16; ++i) m = fmaxf(m, S[kb][i]); }
            m = fmaxf(m, __shfl_xor(m, 32));
            float sum = 0.f;
#pragma unroll
            for (int kb = 0; kb < 6; ++kb) if (kb < nkb) {
#pragma unroll
                for (int i = 0; i < 16; ++i) { const float e = __expf(S[kb][i] - m); S[kb][i] = e; sum += e; } }
            sum += __shfl_xor(sum, 32);
            const float inv = 1.f / (sum + __expf(sink - m));
            f32x16 O[2];
#pragma unroll
            for (int db = 0; db < 2; ++db)
#pragma unroll
                for (int i = 0; i < 16; ++i) O[db][i] = 0.f;
#pragma unroll
            for (int kb = 0; kb < 6; ++kb) if (kb < nkb) {
#pragma unroll
                for (int i = 0; i < 16; ++i) S[kb][i] *= inv;
#pragma unroll
                for (int st = 0; st < 2; ++st) {
                    const bf16x8 A = PACK8(S[kb], st);
#pragma unroll
                    for (int db = 0; db < 2; ++db) { const bf16x8 Bv = ld2x8(VT + (32 * db + c31) * 392 + (32 * kb + 16 * st + 4 * h) * 2); O[db] = MFMA32(A, Bv, O[db]); }
                }
            }
#pragma unroll
            for (int db = 0; db < 2; ++db)
#pragma unroll
                for (int i4 = 0; i4 < 4; ++i4)
#pragma unroll
                    for (int j = 0; j < 4; ++j) *(LAS bf16_t*)(OS + (8 * i4 + 4 * h + j) * 128 + (32 * db + c31) * 2) = f2bf(O[db][4 * i4 + j]);
            asm volatile("s_waitcnt lgkmcnt(0)" ::: "memory");
#pragma unroll
            for (int it = 0; it < 4; ++it) { const int row = it * 8 + (lane >> 3), ch = lane & 7;
                const u32x4 v = *(const LAS u32x4*)(OS + row * 128 + ch * 16);
                *(u32x4*)(YA + (size_t)(qrow0 + qh * 32 + row) * 1024 + hq * 64 + ch * 8) = v; }
        }
        __syncthreads();
    }
#undef ATT_ISSUE
}

#define XB_TMO      128
#define XB_XCNT(j)  (256  + 64 * (j))
#define XB_XSUB(j)  (1280 + 64 * (j))
#define XB_XGEN(j)  (2304 + 64 * (j))
#define XB_TOP      3328
#define XB_TOPGEN   3392
#define XCD_BAR_WORDS 3456
#define XB_SPIN_CAP (1u << 18)

__device__ __forceinline__ unsigned xb_ld(unsigned* p)              { return __hip_atomic_load(p, __ATOMIC_RELAXED, __HIP_MEMORY_SCOPE_AGENT); }
__device__ __forceinline__ unsigned xb_add(unsigned* p, unsigned v) { return __hip_atomic_fetch_add(p, v, __ATOMIC_RELAXED, __HIP_MEMORY_SCOPE_AGENT); }
__device__ __forceinline__ unsigned xb_xcc_id() { return (unsigned)__builtin_amdgcn_s_getreg((3 << 11) | 20) & 0xFu; }
#define XB_SPIN(cond, bar) do { unsigned _sp = 0; while (cond) { __builtin_amdgcn_s_sleep(1); \
    if ((++_sp & 255u) == 0u) { if (xb_ld(&(bar)[XB_TMO])) break; if (_sp > XB_SPIN_CAP) { atomicAdd(&(bar)[XB_TMO], 1u); break; } } } } while (0)

struct XcdBarrier {
    unsigned* bar; unsigned x;
    volatile LAS unsigned* st;
};

__device__ __forceinline__ XcdBarrier xcd_barrier_post(unsigned* bar, volatile LAS unsigned* st) {
    XcdBarrier b; b.bar = bar; b.x = xb_xcc_id(); b.st = st;
    if (threadIdx.x == 0) (void)xb_add(&bar[XB_XCNT(b.x)], 1u);
    return b;
}
__device__ __forceinline__ void xcd_barrier_complete(unsigned* bar, unsigned x, unsigned& nloc, unsigned& nx) {
    const unsigned G = gridDim.x * gridDim.y * gridDim.z;
    unsigned sum, cnt, mine, sp = 0u;
    for (;;) {
        sum = 0u; cnt = 0u; mine = 0u;
#pragma unroll
        for (unsigned j = 0; j < 16; ++j) { const unsigned c = xb_ld(&bar[XB_XCNT(j)]); sum += c; cnt += (c > 0u) ? 1u : 0u; mine = (j == x) ? c : mine; }
        if (sum == G) break;
        __builtin_amdgcn_s_sleep(1);
        if ((++sp & 255u) == 0u) { if (xb_ld(&bar[XB_TMO])) break; if (sp > XB_SPIN_CAP) { atomicAdd(&bar[XB_TMO], 1u); break; } }
    }
    nloc = mine > 0u ? mine : 1u; nx = cnt > 0u ? cnt : 1u;
}

__device__ __forceinline__ void xcd_barrier(const XcdBarrier& b) {
    asm volatile("s_waitcnt vmcnt(0)" ::: "memory");
    __syncthreads();
    if (threadIdx.x == 0) {
        unsigned* bar = b.bar;
        __builtin_amdgcn_s_waitcnt(0);
        unsigned nloc = b.st[0], nx = b.st[1];
        if (nloc == 0u) { xcd_barrier_complete(bar, b.x, nloc, nx); b.st[0] = nloc; b.st[1] = nx; }
        const unsigned old = xb_add(&bar[XB_XSUB(b.x)], 1u);
        const unsigned gen = old / nloc;
        if (old + 1u == (gen + 1u) * nloc) {
            __builtin_amdgcn_fence(__ATOMIC_RELEASE, "agent");
            asm volatile("s_waitcnt vmcnt(0)" ::: "memory");
            const unsigned og = xb_add(&bar[XB_TOP], 1u);
            const unsigned tg = og / nx;
            if (og + 1u == (tg + 1u) * nx) xb_add(&bar[XB_TOPGEN], 1u);
            else XB_SPIN(xb_ld(&bar[XB_TOPGEN]) == tg, bar);
            __builtin_amdgcn_fence(__ATOMIC_ACQUIRE, "agent");
            xb_add(&bar[XB_XGEN(b.x)], 1u);
            asm volatile("s_waitcnt vmcnt(0)" ::: "memory");
        } else {
            XB_SPIN(xb_ld(&bar[XB_XGEN(b.x)]) == gen, bar);
            __builtin_amdgcn_fence(__ATOMIC_ACQUIRE, "agent");
            asm volatile("s_waitcnt vmcnt(0)" ::: "memory");
        }
    }
    __syncthreads();
}

#ifndef DUP_GEMM
#define DUP_GEMM 1
#endif
#ifndef DUPG0
#define DUPG0 DUP_GEMM
#endif
#ifndef DUPG1
#define DUPG1 DUP_GEMM
#endif
#ifndef DUPG2
#define DUPG2 DUP_GEMM
#endif
#ifndef DUPG3
#define DUPG3 DUP_GEMM
#endif
#ifndef DUPG4
#define DUPG4 DUP_GEMM
#endif
#ifndef DUPG5
#define DUPG5 DUP_GEMM
#endif
#ifndef DUPG6
#define DUPG6 DUP_GEMM
#endif
#ifndef FFN_WGM
#define FFN_WGM 4
#endif
#ifndef PROJ_ALIGN
#define PROJ_ALIGN true
#endif
#ifndef PROJ_WGM
#define PROJ_WGM 4
#endif
#ifndef DUP_SYNC
#define DUP_SYNC 1
#endif
#define GSYNC() do { for (int rs_ = 0; rs_ < DUP_SYNC; ++rs_) xcd_barrier(xbar); } while (0)
__global__ void __launch_bounds__(512, 2) fwd_megakernel(Params P) {
    extern __shared__ __attribute__((aligned(16))) unsigned char lds_raw[];
    LAS unsigned char* lds = (LAS unsigned char*)lds_raw;
    cg::grid_group grid = cg::this_grid();
    const int G = gridDim.x, bid = blockIdx.x;

    if (threadIdx.x < 64) ((volatile LAS unsigned*)(lds + 131072))[threadIdx.x] = 0u;
    if (bid == 0) for (int i = threadIdx.x; i < 4096; i += 512) ((unsigned*)(P.ws + OFF_BAR))[i] = 0u;
    __syncthreads();
    phase0(P, lds);
    grid.sync();
    XcdBarrier xbar = xcd_barrier_post((unsigned*)(P.ws + OFF_BAR), (volatile LAS unsigned*)(lds + 131072) + 8);

    for (int gi = 0; gi < 2; ++gi) {
        const int g0 = gi ? G_BASE1 : 0, rows = gi ? RG : 32768;
        rowpass1(P, g0, rows);
        GSYNC();
        for (int rep = 0; rep < DUPG0; ++rep)
        { pg8::Gemm g{(const bf16_t*)(P.ws + OFF_HN), (const bf16_t*)(P.ws + OFF_WIN), rows, NPROJ, 1024}; pg8::StaticOrder S; S.init(rows, NPROJ, G, bid); S.wgm = PROJ_WGM;
          EpiProj E{P.ws, P.out, P.ssm_dt_bias, g0};
          pg8::gemm_phase<EpiProj, pg8::StaticOrder, PROJ_ALIGN, true>(lds, g, S, E); }
        GSYNC();
        {
            constexpr int NCONV = 132, A0 = 1664;
            const int natt = 2048 + (gi ? 64 : 0);
            for (int stage = 0; stage < 3; ++stage) {
                if (stage == 0) { if (bid < NCONV) conv_pass(P, gi, bid, NCONV); }
                else if (stage == 1) { for (int u = bid; u < 192; u += G) ssd_unit<0>(P, lds, g0, gi * 8 + u / 24, (u / 3) & 7, 0, u % 3); }
                else {
                    const int nss = (gi == 1 && bid < 128) ? 2 : 1;
                    for (int k = 0; k < nss; ++k) {
                        if (k == 0 && bid >= 256) continue;
                        ssd_unit<1>(P, lds, g0, k ? (bid >> 3) : gi * 8 + (bid >> 5), k ? (bid & 7) : ((bid >> 2) & 7), k, bid & 3); }
                }
                int u0 = natt, u1 = natt, ustep = 1;
                if (stage == 0 && bid >= NCONV) { u0 = bid - NCONV; u1 = A0; ustep = G - NCONV; }
                if (stage == 1 && bid >= 192) { u0 = A0 + (bid - 192); u1 = natt; ustep = G - 192; }
                attn_range(P, lds, g0, gi, u0, u1, ustep);
                if (stage < 2) GSYNC();
            }
        }
        GSYNC();
        for (int rep = 0; rep < DUPG1; ++rep)
        { pg8::Gemm g{(const bf16_t*)(P.ws + OFF_YS), (const bf16_t*)(P.ws + OFF_WSSM), rows, 1024, 2048}; pg8::StaticOrder S; S.init(rows, 1024, G, bid);
          EpiGateA E{P.ws};
          pg8::gemm_phase<EpiGateA, pg8::StaticOrder, true, true>(lds, g, S, E); }
        __syncthreads();
        for (int rep = 0; rep < DUPG2; ++rep)
        { pg8::Gemm g{(const bf16_t*)(P.ws + OFF_Q), (const bf16_t*)(P.ws + OFF_WATT), rows, 1024, 1024}; pg8::StaticOrder S; S.init(rows, 1024, G, bid);
          EpiGateB E{P.ws};
          pg8::gemm_phase<EpiGateB, pg8::StaticOrder, true, true>(lds, g, S, E); }
        GSYNC();
        for (int rep = 0; rep < DUPG3; ++rep)
        { pg8::Gemm g{(const bf16_t*)(P.ws + OFF_MRG), (const bf16_t*)(P.ws + OFF_WOUT), rows, 1024, 1024}; pg8::StaticOrder S; S.init(rows, 1024, G, bid);
          EpiB16 E{(bf16_t*)(P.ws + OFF_O)};
          pg8::gemm_phase<EpiB16, pg8::StaticOrder, true, true>(lds, g, S, E); }
        GSYNC();
        rowpass2(P, g0, rows);
        GSYNC();
        for (int rep = 0; rep < DUPG4; ++rep)
        { pg8::Gemm g{(const bf16_t*)(P.ws + OFF_HN), (const bf16_t*)(P.ws + OFF_WFIN), rows, DFF, 1024}; pg8::StaticOrder S; S.init(rows, DFF, G, bid); S.wgm = FFN_WGM;
          EpiG E{P.ws, P.out, g0};
          pg8::gemm_phase<EpiG, pg8::StaticOrder, true, true>(lds, g, S, E); }
        GSYNC();
        for (int rep = 0; rep < DUPG5; ++rep)
        { pg8::Gemm g{(const bf16_t*)(P.ws + OFF_HN), (const bf16_t*)(P.ws + OFF_WFIN) + (size_t)DFF * 1024, rows, DFF, 1024}; pg8::StaticOrder S; S.init(rows, DFF, G, bid); S.wgm = FFN_WGM;
          EpiU E{P.ws, P.ffn_conv_w, P.ffn_conv_b, P.state_ffn, g0};
          pg8::gemm_phase<EpiU, pg8::StaticOrder, true, true>(lds, g, S, E); }
        GSYNC();
        for (int rep = 0; rep < DUPG6; ++rep)
        { pg8::Gemm g{(const bf16_t*)(P.ws + OFF_ACT), (const bf16_t*)(P.ws + OFF_WFOUT), rows, 1024, DFF}; pg8::StaticOrder S; S.init(rows, 1024, G, bid);
          EpiB16 E{(bf16_t*)(P.ws + OFF_F)};
          pg8::gemm_phase<EpiB16, pg8::StaticOrder, true, true>(lds, g, S, E); }
        GSYNC();
        rowpass3(P, g0, rows);
    }
}

extern "C" void kernel_launch(void* const* d_in, const int* in_sizes, int n_in, void* d_out, int out_size, void* d_ws, size_t ws_size, hipStream_t stream) {
    static int grid = 0;
    if (grid == 0) {
        if (n_in != 30 || (size_t)out_size != OUT_TOTAL || ws_size < WS_END) {
            fprintf(stderr, "kernel_launch: unexpected shapes: n_in %d out %d (want %zu) ws %zu (need %zu)\n", n_in, out_size, (size_t)OUT_TOTAL, ws_size, (size_t)WS_END); grid = -1; return; }
        int dev = 0, cus = 0, per_cu = 0;
        hipGetDevice(&dev); hipDeviceGetAttribute(&cus, hipDeviceAttributeMultiprocessorCount, dev);
        if (hipFuncSetAttribute((const void*)fwd_megakernel, hipFuncAttributeMaxDynamicSharedMemorySize, LDS_BYTES) != hipSuccess) { fprintf(stderr, "kernel_launch: hipFuncSetAttribute failed\n"); grid = -1; return; }
        if (hipOccupancyMaxActiveBlocksPerMultiprocessor(&per_cu, (const void*)fwd_megakernel, 512, LDS_BYTES) != hipSuccess || per_cu < 1) { fprintf(stderr, "kernel_launch: occupancy query says %d\n", per_cu); per_cu = 1; }
        (void)hipGetLastError();
        grid = cus;
        if (grid < 128) { fprintf(stderr, "kernel_launch: needs >= 128 CUs, got %d\n", grid); grid = -1; return; }
    }
    if (grid < 0) return;
    Params p{};
    const float** pp = (const float**)&p;
    for (int i = 0; i < 30; ++i) pp[i] = (const float*)d_in[i];
    p.out = (float*)d_out; p.ws = (unsigned char*)d_ws;
    void* args[] = {&p};
    hipError_t e = hipLaunchCooperativeKernel((const void*)fwd_megakernel, dim3(grid), dim3(512), args, LDS_BYTES, stream);
    if (e != hipSuccess) fprintf(stderr, "cooperative launch failed: %s (grid %d)\n", hipGetErrorString(e), grid);
}
```

```cpp
#include <hip/hip_runtime.h>
#include <hip/hip_cooperative_groups.h>
#include <cstdio>
#include <cstdint>
namespace cg = cooperative_groups;
namespace pg8 {
#define PG8_LAS __attribute__((address_space(3)))
typedef unsigned short bf16_t;
typedef short bf16x8 __attribute__((ext_vector_type(8)));
typedef float f32x4 __attribute__((ext_vector_type(4)));
typedef unsigned u32x4 __attribute__((ext_vector_type(4)));
constexpr int BM = 256, BK = 64, HALF = 128, HTB = HALF * BK * 2  , STAGE_BYTES = 8 * HTB, NXCD = 8, WGM = 8;

__host__ __device__ __forceinline__ int lds_byte(int r, int c) { const int st = (r >> 4) * 2 + (c >> 5), rr = r & 15, cc = c & 31, ob = rr * 64 + cc * 2; return st * 1024 + (ob ^ (((ob >> 9) & 1) << 5)); }
__host__ __device__ __forceinline__ void stage_rc(int b, int& R, int& C) { const int st = b / 1024, sb = b % 1024, swz = sb ^ (((sb >> 9) & 1) << 5); R = (st >> 1) * 16 + swz / 64; C = (st & 1) * 32 + (swz % 64) / 2; }
__host__ __device__ __forceinline__ int perm32(int rho) { const int n = rho >> 4, i = rho & 15; return 8 * (i >> 2) + 4 * n + (i & 3); }

struct Unit { int pm, pn; };
struct Gemm { const bf16_t* A; const bf16_t* Bt; int M, N, K; };

struct StaticOrder {
    int nM, nN, nwg, G, c, wgm = 8;
    __host__ __device__ __forceinline__ void init(int M, int N, int G_, int c_) { nM = M / BM; nN = N / BM; nwg = nM * nN; G = G_; c = c_; }
    __host__ __device__ __forceinline__ bool next(int i, Unit& u) const {
        const long L = (long)i * G + c; if (L >= nwg) return false;
        int wgid = (int)L; { const int q = nwg / NXCD, r = nwg % NXCD, xcd = wgid % NXCD, off = wgid / NXCD; wgid = (xcd < r ? xcd * (q + 1) : r * (q + 1) + (xcd - r) * q) + off; }
        const int nig = wgm * nN, gid = wgid / nig, fm = gid * wgm, gsz = (nM - fm) < wgm ? (nM - fm) : wgm;
        u.pm = fm + ((wgid % nig) % gsz); u.pn = (wgid % nig) / gsz; return true;
    }
    __device__ __forceinline__ void a_ready(const Unit&) const {}
    __device__ __forceinline__ void done(const Unit&) const {}
};
template <class Epi, class Sched, bool ALIGN_EPI = false, bool SP2 = false>
__device__ __forceinline__ void gemm_phase(PG8_LAS unsigned char* lds, const Gemm g, const Sched& S, const Epi& E) {
    int tid_l = threadIdx.x; asm volatile("" : "+v"(tid_l));
    const int tid = tid_l, wid = __builtin_amdgcn_readfirstlane(tid >> 6), lane = tid & 63, wr = wid >> 2, wc = wid & 3, fr = lane & 15, fq = lane >> 4;
    const int K = g.K, nt = K / BK;
    unsigned voffA[2], voffB[2];
#pragma unroll
    for (int i = 0; i < 2; ++i) { int R, C; stage_rc(tid * 16 + i * 8192, R, C); const int Rb = Epi::PERM ? ((R & ~31) + perm32(R & 31)) : R;
        voffA[i] = (unsigned)(R * K + C) * 2u; voffB[i] = (unsigned)(Rb * K + C) * 2u; }
    const size_t kstep = (size_t)(BK * 2);
    const size_t hstep = (size_t)HALF * K * 2;
    const size_t tstep = 2 * hstep;
    const unsigned ldsw = (unsigned)wid * 1024u;
    const int aoff = lds_byte(wr * 64 + fr, fq * 8), boff = lds_byte(wc * 32 + fr, fq * 8);
#define PG8_SA(b, h) (((b) * 2 + (h)) * HTB)
#define PG8_SB(b, h) ((4 + (b) * 2 + (h)) * HTB)
#define PG8_STAGE(bufoff, gbase, voff) do { _Pragma("unroll") for (int _i = 0; _i < 2; ++_i) \
        __builtin_amdgcn_global_load_lds((const unsigned*)((const char*)(gbase) + (voff)[_i]), (PG8_LAS unsigned*)(lds + (bufoff) + ldsw + _i * 8192), 16, 0, 0); } while (0)
#define PG8_LDA(dst, b, h) do { _Pragma("unroll") for (int m = 0; m < 4; ++m) _Pragma("unroll") for (int k = 0; k < 2; ++k) dst[m][k] = *(const PG8_LAS bf16x8*)(lds + PG8_SA(b, h) + aoff + m * 2048 + k * 1024); } while (0)
#define PG8_LDB(dst, b, h) do { _Pragma("unroll") for (int n = 0; n < 2; ++n) _Pragma("unroll") for (int k = 0; k < 2; ++k) dst[n][k] = *(const PG8_LAS bf16x8*)(lds + PG8_SB(b, h) + boff + n * 2048 + k * 1024); } while (0)
#define PG8_MMA(ai, bj, At, Bt) do { __builtin_amdgcn_s_setprio(1); _Pragma("unroll") for (int m = 0; m < 4; ++m) _Pragma("unroll") for (int n = 0; n < 2; ++n) _Pragma("unroll") for (int k = 0; k < 2; ++k) \
        acc[ai][bj][m][n] = __builtin_amdgcn_mfma_f32_16x16x32_bf16(Bt[n][k], At[m][k], acc[ai][bj][m][n], 0, 0, 0); __builtin_amdgcn_s_setprio(0); } while (0)
#define PG8_WAIT_V(n) asm volatile("s_waitcnt vmcnt(" #n ")" ::: "memory")
#define PG8_WAIT_L(n) asm volatile("s_waitcnt lgkmcnt(" #n ")" ::: "memory")
#define PG8_BAR __builtin_amdgcn_s_barrier()
#define PG8_SCHED __builtin_amdgcn_sched_barrier(0)
    Unit cur, nxt; int ui = 0;
    if (!S.next(0, cur)) return;
    f32x4 acc[2][2][4][2];
#pragma unroll
    for (int a = 0; a < 2; ++a)
#pragma unroll
        for (int b = 0; b < 2; ++b)
#pragma unroll
            for (int m = 0; m < 4; ++m)
#pragma unroll
                for (int n = 0; n < 2; ++n) acc[a][b][m][n] = (f32x4){0.f, 0.f, 0.f, 0.f};
    bf16x8 At[4][2], B0[2][2], B1[2][2];
    const char* cA = (const char*)g.A + (size_t)cur.pm * tstep; const char* cB = (const char*)g.Bt + (size_t)cur.pn * tstep;
    S.a_ready(cur);
    if constexpr (SP2) {
        PG8_STAGE(PG8_SB(0, 0), cB, voffB); PG8_STAGE(PG8_SB(0, 1), cB + hstep, voffB); PG8_STAGE(PG8_SA(0, 0), cA, voffA); PG8_STAGE(PG8_SA(0, 1), cA + hstep, voffA);
        if (wr == 1) PG8_BAR;
        PG8_WAIT_V(2); PG8_BAR;
        PG8_STAGE(PG8_SB(1, 0), cB + kstep, voffB); PG8_STAGE(PG8_SA(1, 0), cA + kstep, voffA); PG8_STAGE(PG8_SB(1, 1), cB + hstep + kstep, voffB);
        PG8_WAIT_V(6); PG8_BAR;
    } else {
        PG8_STAGE(PG8_SB(0, 0), cB, voffB); PG8_STAGE(PG8_SA(0, 0), cA, voffA); PG8_STAGE(PG8_SB(0, 1), cB + hstep, voffB); PG8_STAGE(PG8_SA(0, 1), cA + hstep, voffA);
        if (wr == 1) PG8_BAR;
        PG8_WAIT_V(4); PG8_BAR;
        PG8_STAGE(PG8_SB(1, 0), cB + kstep, voffB); PG8_STAGE(PG8_SA(1, 0), cA + kstep, voffA); PG8_STAGE(PG8_SB(1, 1), cB + hstep + kstep, voffB);
        PG8_WAIT_V(6); PG8_BAR;
    }
    for (;;) {
        const bool has_next = S.next(ui + 1, nxt);
        const char* nA = has_next ? (const char*)g.A + (size_t)nxt.pm * tstep : cA; const char* nB = has_next ? (const char*)g.Bt + (size_t)nxt.pn * tstep : cB;
        for (int t = 0; t < nt; t += 2) {
            const bool last = (t == nt - 2);
            const char* a1 = cA + (size_t)(t + 1) * kstep;
            const char* a2 = last ? nA : cA + (size_t)(t + 2) * kstep; const char* b2 = last ? nB : cB + (size_t)(t + 2) * kstep;
            const char* a3 = a2 + kstep; const char* b3 = b2 + kstep;
            if (last && has_next) S.a_ready(nxt);
            if constexpr (SP2) {
            PG8_LDB(B0, 0, 0); PG8_LDB(B1, 0, 1); PG8_SCHED; PG8_LDA(At, 0, 0); PG8_STAGE(PG8_SA(1, 1), a1 + hstep, voffA);
            PG8_WAIT_V(8); PG8_WAIT_L(0); PG8_BAR; PG8_MMA(0, 0, At, B0); PG8_MMA(0, 1, At, B1); PG8_BAR; PG8_SCHED;
            PG8_LDA(At, 0, 1); PG8_STAGE(PG8_SB(0, 0), b2, voffB); PG8_STAGE(PG8_SB(0, 1), b2 + hstep, voffB); PG8_STAGE(PG8_SA(0, 0), a2, voffA);
            PG8_WAIT_V(8); PG8_WAIT_L(0); PG8_BAR; PG8_MMA(1, 0, At, B0); PG8_MMA(1, 1, At, B1); PG8_BAR; PG8_SCHED;
            PG8_LDB(B0, 1, 0); PG8_LDB(B1, 1, 1); PG8_SCHED; PG8_LDA(At, 1, 0); PG8_STAGE(PG8_SA(0, 1), a2 + hstep, voffA);
            PG8_WAIT_V(8); PG8_WAIT_L(0); PG8_BAR; PG8_MMA(0, 0, At, B0); PG8_MMA(0, 1, At, B1); PG8_BAR; PG8_SCHED;
            PG8_LDA(At, 1, 1); PG8_STAGE(PG8_SB(1, 0), b3, voffB); PG8_STAGE(PG8_SB(1, 1), b3 + hstep, voffB); PG8_STAGE(PG8_SA(1, 0), a3, voffA);
            PG8_WAIT_V(8); PG8_WAIT_L(0); PG8_BAR; PG8_MMA(1, 0, At, B0); PG8_MMA(1, 1, At, B1); PG8_BAR; PG8_SCHED;
            } else {
            PG8_LDB(B0, 0, 0); PG8_SCHED; PG8_LDA(At, 0, 0); PG8_STAGE(PG8_SA(1, 1), a1 + hstep, voffA);
            PG8_WAIT_L(8); PG8_BAR; PG8_WAIT_L(0); PG8_MMA(0, 0, At, B0); PG8_BAR; PG8_SCHED;
            PG8_LDB(B1, 0, 1); PG8_STAGE(PG8_SB(0, 0), b2, voffB);
            PG8_BAR; PG8_WAIT_L(0); PG8_MMA(0, 1, At, B1); PG8_BAR;
            PG8_LDA(At, 0, 1); PG8_STAGE(PG8_SA(0, 0), a2, voffA);
            PG8_BAR; PG8_WAIT_L(0); PG8_MMA(1, 0, At, B0); PG8_BAR; PG8_SCHED;
            PG8_STAGE(PG8_SB(0, 1), b2 + hstep, voffB);
            PG8_WAIT_V(6); PG8_BAR; PG8_MMA(1, 1, At, B1); PG8_BAR;
            PG8_LDB(B0, 1, 0); PG8_SCHED; PG8_LDA(At, 1, 0); PG8_STAGE(PG8_SA(0, 1), a2 + hstep, voffA);
            PG8_WAIT_L(8); PG8_BAR; PG8_WAIT_L(0); PG8_MMA(0, 0, At, B0); PG8_BAR; PG8_SCHED;
            PG8_LDB(B1, 1, 1); PG8_STAGE(PG8_SB(1, 0), b3, voffB);
            PG8_BAR; PG8_WAIT_L(0); PG8_MMA(0, 1, At, B1); PG8_BAR;
            PG8_LDA(At, 1, 1); PG8_STAGE(PG8_SA(1, 0), a3, voffA);
            PG8_BAR; PG8_WAIT_L(0); PG8_MMA(1, 0, At, B0); PG8_BAR; PG8_SCHED;
            PG8_STAGE(PG8_SB(1, 1), b3 + hstep, voffB);
            PG8_WAIT_V(6); PG8_BAR; PG8_MMA(1, 1, At, B1); PG8_BAR;
            }
        }
        if constexpr (ALIGN_EPI) { if (wr == 0) PG8_BAR; }
        if constexpr (!Epi::AFTER_DRAIN) { E(acc, cur, wr, wc, fr, fq); S.done(cur); }
        if (!has_next) break;
#pragma unroll
        for (int a = 0; a < 2; ++a)
#pragma unroll
            for (int b = 0; b < 2; ++b)
#pragma unroll
                for (int m = 0; m < 4; ++m)
#pragma unroll
                    for (int n = 0; n < 2; ++n) acc[a][b][m][n] = (f32x4){0.f, 0.f, 0.f, 0.f};
        cur = nxt; cA = nA; cB = nB; ++ui;
        if constexpr (ALIGN_EPI) { if (wr == 1) PG8_BAR; }
    }
    PG8_WAIT_V(0);
    if constexpr (!ALIGN_EPI) { if (wr == 0) PG8_BAR; }
    PG8_BAR;
    if constexpr (Epi::AFTER_DRAIN) { E.fused(acc, cur, wr, wc, fr, fq, lds, wid, lane); S.done(cur); }
#undef PG8_SA
#undef PG8_SB
#undef PG8_STAGE
#undef PG8_LDA
#undef PG8_LDB
#undef PG8_MMA
#undef PG8_WAIT_V
#undef PG8_WAIT_L
#undef PG8_BAR
#undef PG8_SCHED
}
}

#define DI __device__ __forceinline__
#define LAS __attribute__((address_space(3)))
typedef unsigned short bf16_t;
typedef short bf16x8 __attribute__((ext_vector_type(8)));
typedef float f32x4 __attribute__((ext_vector_type(4)));
typedef float f32x16 __attribute__((ext_vector_type(16)));
typedef unsigned u32x4 __attribute__((ext_vector_type(4)));
typedef unsigned u32x2 __attribute__((ext_vector_type(2)));
typedef float f32x2_t __attribute__((ext_vector_type(2)));
typedef __bf16 bf16x2_t __attribute__((ext_vector_type(2)));

constexpr int DM = 1024, SEQ = 4096, PROWS = 65536, SROWS = 512;
constexpr int G_BASE1 = 32768, RG = 33280;
constexpr int NPROJ = 9984, DFF = 2816;
constexpr float EPS = 1e-6f;

constexpr size_t OFF_WIN = 0;
constexpr size_t OFF_WSSM = OFF_WIN + (size_t)NPROJ * 1024 * 2;
constexpr size_t OFF_WATT = OFF_WSSM + (size_t)1024 * 2048 * 2;
constexpr size_t OFF_WOUT = OFF_WATT + (size_t)1024 * 1024 * 2;
constexpr size_t OFF_WFIN = OFF_WOUT + (size_t)1024 * 1024 * 2;
constexpr size_t OFF_WFOUT = OFF_WFIN + (size_t)5632 * 1024 * 2;
constexpr size_t OFF_MOD = OFF_WFOUT + (size_t)1024 * 2816 * 2;
constexpr size_t OFF_ROPE = OFF_MOD + (size_t)32 * 6144 * 4;
constexpr size_t OFF_HN = OFF_ROPE + (size_t)4128 * 16 * 4;
constexpr size_t OFF_Z = OFF_HN + (size_t)RG * 1024 * 2;
constexpr size_t OFF_GT = OFF_Z + (size_t)RG * 2048 * 2;
constexpr size_t OFF_XBC = OFF_GT + (size_t)RG * 2048 * 2;
constexpr size_t OFF_Q = OFF_XBC + (size_t)RG * 4096 * 2;
constexpr size_t OFF_K = OFF_Q + (size_t)RG * 1024 * 2;
constexpr size_t OFF_V = OFF_K + (size_t)RG * 256 * 2;
constexpr size_t OFF_DT = OFF_V + (size_t)RG * 256 * 2;
constexpr size_t OFF_YS = OFF_DT + (size_t)RG * 32 * 4;
constexpr size_t OFF_HALO = OFF_YS + (size_t)RG * 2048 * 2;
constexpr size_t OFF_SSF = OFF_HALO + (size_t)(RG / 64) * 3 * 4096 * 2;
constexpr size_t OFF_SSDK = OFF_SSF + (size_t)8 * 8 * 3 * 4 * 8192 * 4;
constexpr size_t OFF_BAR = OFF_SSDK + 4096;
constexpr size_t WS_END = OFF_BAR + 16384;
constexpr size_t OFF_T1 = OFF_XBC;
constexpr size_t OFF_MRG = OFF_HN;
constexpr size_t OFF_O = OFF_Z;
constexpr size_t OFF_GR = OFF_XBC;
constexpr size_t OFF_ACT = OFF_Z;
constexpr size_t OFF_F = OFF_YS;
static_assert(OFF_HN % 256 == 0 && OFF_Z % 256 == 0 && OFF_XBC % 256 == 0 && OFF_YS % 256 == 0, "align");
static_assert((size_t)RG * 2816 * 2 <= (size_t)RG * 4096 * 2, "GR fits XBC");

constexpr size_t OUT_Y = 0;
constexpr size_t OUT_SSM_P = 67108864ull + 524288ull;
constexpr size_t OUT_CONV_P = OUT_SSM_P + 4194304ull;
constexpr size_t OUT_K_P = OUT_CONV_P + 196608ull;
constexpr size_t OUT_V_P = OUT_K_P + 524288ull;
constexpr size_t OUT_FFN_P = OUT_V_P + 524288ull;
constexpr size_t OUT_SSM_S = OUT_FFN_P + 90112ull;
constexpr size_t OUT_CONV_S = OUT_SSM_S + 4194304ull;
constexpr size_t OUT_K_S = OUT_CONV_S + 196608ull;
constexpr size_t OUT_V_S = OUT_K_S + 524288ull;
constexpr size_t OUT_FFN_S = OUT_V_S + 524288ull;
constexpr size_t OUT_TOTAL = OUT_FFN_S + 90112ull;

constexpr int LDS_BYTES = 132096;

struct Params {
    const float* x_prompt; const float* x_sample; const float* cache_k; const float* cache_v; const float* state_ssm; const float* state_conv;
    const float* state_ffn; const float* c_prompt; const float* c_sample; const float* w_ada; const float* b_ada; const float* norm_mix_pre;
    const float* norm_mix_post; const float* w_in; const float* ssm_conv_w; const float* ssm_conv_b; const float* ssm_dt_bias; const float* ssm_a_log;
    const float* ssm_d; const float* ssm_norm; const float* attn_sinks; const float* w_ssm_out; const float* w_att_out; const float* w_out;
    const float* norm_ffn_pre; const float* norm_ffn_post; const float* w_ffn_in; const float* ffn_conv_w; const float* ffn_conv_b; const float* w_ffn_out;
    float* out; unsigned char* ws;
};

DI unsigned pk2(float lo, float hi) { f32x2_t v = {lo, hi}; bf16x2_t b = __builtin_convertvector(v, bf16x2_t); return __builtin_bit_cast(unsigned, b); }
DI bf16_t f2bf(float f) { return (bf16_t)(pk2(f, 0.f) & 0xffffu); }
DI float bf2f(unsigned u16) { return __uint_as_float(u16 << 16); }
DI float bflo(unsigned w) { return __uint_as_float(w << 16); }
DI float bfhi(unsigned w) { return __uint_as_float(w & 0xffff0000u); }
DI u32x4 pack8f(const float* v) { u32x4 r; r.x = pk2(v[0], v[1]); r.y = pk2(v[2], v[3]); r.z = pk2(v[4], v[5]); r.w = pk2(v[6], v[7]); return r; }
DI float silu_f(float v) { return v * __builtin_amdgcn_rcpf(1.f + __expf(-v)); }
DI float sigmoid_f(float v) { return __builtin_amdgcn_rcpf(1.f + __expf(-v)); }
DI float wave_sum(float v) {
#pragma unroll
    for (int o = 1; o < 64; o <<= 1) v += __shfl_xor(v, o);
    return v;
}
DI void row_info(int grow, int& b, int& t, int& smp) {
    if (grow < PROWS) { b = grow >> 12; t = grow & 4095; smp = 0; } else { const int rr = grow - PROWS; b = rr >> 5; t = rr & 31; smp = 1; }
}
#define MFMA32(a, b, c) __builtin_amdgcn_mfma_f32_32x32x16_bf16((a), (b), (c), 0, 0, 0)
DI bf16x8 ld2x8(const LAS unsigned char* p) {
    const u32x2 lo = *(const LAS u32x2*)p; const u32x2 hi = *(const LAS u32x2*)(p + 16);
    u32x4 r; r.x = lo.x; r.y = lo.y; r.z = hi.x; r.w = hi.y; return __builtin_bit_cast(bf16x8, r);
}
#define PACK8(x, s) __builtin_bit_cast(bf16x8, (u32x4){pk2((x)[8 * (s)], (x)[8 * (s) + 1]), pk2((x)[8 * (s) + 2], (x)[8 * (s) + 3]), pk2((x)[8 * (s) + 4], (x)[8 * (s) + 5]), pk2((x)[8 * (s) + 6], (x)[8 * (s) + 7])})

#define EPI_LOOP_BEGIN \
    _Pragma("unroll") for (int ai = 0; ai < 2; ++ai) _Pragma("unroll") for (int m = 0; m < 4; ++m) { \
        const int lr = u.pm * 256 + ai * 128 + wr * 64 + m * 16 + fr; (void)lr; \
        _Pragma("unroll") for (int bj = 0; bj < 2; ++bj) { \
            const int cb = bj * 128 + wc * 32 + 8 * fq; (void)cb; \
            float v[8]; { const pg8::f32x4 a0 = acc[ai][bj][m][0], a1 = acc[ai][bj][m][1]; v[0] = a0[0]; v[1] = a0[1]; v[2] = a0[2]; v[3] = a0[3]; v[4] = a1[0]; v[5] = a1[1]; v[6] = a1[2]; v[7] = a1[3]; }
#define EPI_LOOP_END } }
#define EPI_ROW(mm) (u.pm * 256 + ai * 128 + wr * 64 + (2 * mh + (mm)) * 16 + fr)
#define EPI_CB(bj) ((bj) * 128 + wc * 32 + 8 * fq)
#define EPI_V8(mm, bj) float v[8]; { const pg8::f32x4 a0 = acc[ai][bj][2 * mh + (mm)][0], a1 = acc[ai][bj][2 * mh + (mm)][1]; v[0] = a0[0]; v[1] = a0[1]; v[2] = a0[2]; v[3] = a0[3]; v[4] = a1[0]; v[5] = a1[1]; v[6] = a1[2]; v[7] = a1[3]; }

struct EpiProj {
    static constexpr bool PERM = true, AFTER_DRAIN = false;
    unsigned char* ws; float* out; const float* dt_bias; int g0;
    DI void operator()(const pg8::f32x4 (&acc)[2][2][4][2], const pg8::Unit& u, int wr, int wc, int fr_, int fq_) const {
        int fr = fr_, fq = fq_; asm volatile("" : "+v"(fr), "+v"(fq));
        const int pn = u.pn;
        if (pn < 8) {
            bf16_t* Z = (bf16_t*)(ws + OFF_Z);
            EPI_LOOP_BEGIN
#pragma unroll
                for (int e = 0; e < 8; ++e) v[e] = silu_f(v[e]);
                __builtin_nontemporal_store(pack8f(v), (u32x4*)(Z + (size_t)lr * 2048 + pn * 256 + cb));
            EPI_LOOP_END
        } else if (pn < 24) {
            bf16_t* X = (bf16_t*)(ws + OFF_XBC);
            const bool smp_tile = (g0 + u.pm * 256) >= PROWS, tail_tile = smp_tile || ((u.pm & 15) == 15);
            EPI_LOOP_BEGIN
                const int col = (pn - 8) * 256 + cb;
                const u32x4 pk = pack8f(v);
                __builtin_nontemporal_store(pk, (u32x4*)(X + (size_t)lr * 4096 + col));
                if (m == 3 && !smp_tile) { const int t63 = lr & 63; if (t63 >= 61) *(u32x4*)((bf16_t*)(ws + OFF_HALO) + ((size_t)(lr >> 6) * 3 + (t63 - 61)) * 4096 + col) = pk; }
                if (tail_tile) {
                    int b, t, smp; row_info(g0 + lr, b, t, smp);
                    float* dst = nullptr;
                    if (!smp) { if (t >= SEQ - 3) dst = out + OUT_CONV_P + (size_t)(b * 3 + (t - (SEQ - 3))) * 4096 + col; }
                    else { if (t >= 29) dst = out + OUT_CONV_S + (size_t)(b * 3 + (t - 29)) * 4096 + col; }
                    if (dst) { *(f32x4*)dst = (f32x4){v[0], v[1], v[2], v[3]}; *(f32x4*)(dst + 4) = (f32x4){v[4], v[5], v[6], v[7]}; }
                }
            EPI_LOOP_END
        } else if (pn < 29) {
            const bool isq = pn < 28;
            bf16_t* D = isq ? (bf16_t*)(ws + OFF_Q) : (bf16_t*)(ws + OFF_K);
            const int ld = isq ? 1024 : 256, cbase = isq ? (pn - 24) * 256 : 0;
            const float* rope = (const float*)(ws + OFF_ROPE);
#pragma unroll
            for (int ai = 0; ai < 2; ++ai)
#pragma unroll
                for (int mh = 0; mh < 2; ++mh) {
                    f32x4 tb[2][4];
#pragma unroll
                    for (int mm = 0; mm < 2; ++mm) { int b, t, smp; row_info(g0 + EPI_ROW(mm), b, t, smp); const float* tr = rope + (size_t)(smp ? 4096 + t : t) * 16;
#pragma unroll
                        for (int k = 0; k < 4; ++k) tb[mm][k] = *(const f32x4*)(tr + 4 * k); }
#pragma unroll
                    for (int mm = 0; mm < 2; ++mm)
#pragma unroll
                        for (int bj = 0; bj < 2; ++bj) {
                            EPI_V8(mm, bj)
                            const int lr = EPI_ROW(mm), cb = EPI_CB(bj);
                            int b, t, smp; row_info(g0 + lr, b, t, smp);
                            if ((wc & 1) == 0) {
                                const f32x4 c0 = tb[mm][0], c1 = tb[mm][1], s0 = tb[mm][2], s1 = tb[mm][3];
                                const float cs[8] = {c0[0], c0[1], c0[2], c0[3], c1[0], c1[1], c1[2], c1[3]}, sn[8] = {s0[0], s0[1], s0[2], s0[3], s1[0], s1[1], s1[2], s1[3]};
#pragma unroll
                                for (int e = 0; e < 8; ++e) {
                                    const float other = __shfl_xor(v[e], 16);
                                    const float r0 = v[e] * cs[e] - other * sn[e], r1 = v[e] * cs[e] + other * sn[e];
                                    v[e] = fq == 0 ? r0 : (fq == 1 ? r1 : v[e]);
                                }
                            }
                            if (isq) {
#pragma unroll
                                for (int e = 0; e < 8; ++e) v[e] *= 0.125f;
                            } else {
                                float* dst = nullptr;
                                if (!smp) { if (t >= SEQ - 128) dst = out + OUT_K_P + (size_t)(b * 128 + (t - (SEQ - 128))) * 256 + cb; }
                                else dst = out + OUT_K_S + (size_t)(b * 128 + 96 + t) * 256 + cb;
                                if (dst) { *(f32x4*)dst = (f32x4){v[0], v[1], v[2], v[3]}; *(f32x4*)(dst + 4) = (f32x4){v[4], v[5], v[6], v[7]}; }
                            }
                            __builtin_nontemporal_store(pack8f(v), (u32x4*)(D + (size_t)lr * ld + cbase + cb));
                        }
                }
        } else if (pn == 29) {
            bf16_t* D = (bf16_t*)(ws + OFF_V);
            EPI_LOOP_BEGIN
                int b, t, smp; row_info(g0 + lr, b, t, smp);
                float* dst = nullptr;
                if (!smp) { if (t >= SEQ - 128) dst = out + OUT_V_P + (size_t)(b * 128 + (t - (SEQ - 128))) * 256 + cb; }
                else dst = out + OUT_V_S + (size_t)(b * 128 + 96 + t) * 256 + cb;
                if (dst) { *(f32x4*)dst = (f32x4){v[0], v[1], v[2], v[3]}; *(f32x4*)(dst + 4) = (f32x4){v[4], v[5], v[6], v[7]}; }
                __builtin_nontemporal_store(pack8f(v), (u32x4*)(D + (size_t)lr * 256 + cb));
            EPI_LOOP_END
        } else if (pn < 38) {
            bf16_t* D = (bf16_t*)(ws + OFF_GT);
            EPI_LOOP_BEGIN
#pragma unroll
                for (int e = 0; e < 8; ++e) v[e] = sigmoid_f(v[e]);
                __builtin_nontemporal_store(pack8f(v), (u32x4*)(D + (size_t)lr * 2048 + (pn - 30) * 256 + cb));
            EPI_LOOP_END
        } else {
            float* D = (float*)(ws + OFF_DT);
            EPI_LOOP_BEGIN
                if (cb < 32) {
#pragma unroll
                    for (int e = 0; e < 8; ++e) { const float xx = v[e] + dt_bias[cb + e]; v[e] = fmaxf(xx, 0.f) + __logf(1.f + __expf(-fabsf(xx))); }
                    float* dst = D + (size_t)lr * 32 + cb;
                    *(f32x4*)dst = (f32x4){v[0], v[1], v[2], v[3]}; *(f32x4*)(dst + 4) = (f32x4){v[4], v[5], v[6], v[7]};
                }
            EPI_LOOP_END
        }
    }
};

#define EPI_ROW4(mq) (u.pm * 256 + ai * 128 + wr * 64 + (mq) * 16 + fr)
#define EPI_V8M(mq, bj) float v[8]; { const pg8::f32x4 a0 = acc[ai][bj][mq][0], a1 = acc[ai][bj][mq][1]; v[0] = a0[0]; v[1] = a0[1]; v[2] = a0[2]; v[3] = a0[3]; v[4] = a1[0]; v[5] = a1[1]; v[6] = a1[2]; v[7] = a1[3]; }
struct EpiGateA {
    static constexpr bool PERM = true, AFTER_DRAIN = false;
    unsigned char* ws;
    DI void operator()(const pg8::f32x4 (&acc)[2][2][4][2], const pg8::Unit& u, int wr, int wc, int fr_, int fq_) const {
        int fr = fr_, fq = fq_; asm volatile("" : "+v"(fr), "+v"(fq));
        const bf16_t* GT = (const bf16_t*)(ws + OFF_GT); bf16_t* T1 = (bf16_t*)(ws + OFF_T1);
#pragma unroll
        for (int ai = 0; ai < 2; ++ai) {
            u32x4 gq[4][2];
#pragma unroll
            for (int mq = 0; mq < 4; ++mq)
#pragma unroll
                for (int bj = 0; bj < 2; ++bj) gq[mq][bj] = *(const u32x4*)(GT + (size_t)EPI_ROW4(mq) * 2048 + u.pn * 256 + EPI_CB(bj));
#pragma unroll
            for (int mq = 0; mq < 4; ++mq)
#pragma unroll
                for (int bj = 0; bj < 2; ++bj) {
                    EPI_V8M(mq, bj)
                    const u32x4 g = gq[mq][bj];
                    float o[8];
                    o[0] = v[0] * bflo(g.x); o[1] = v[1] * bfhi(g.x); o[2] = v[2] * bflo(g.y); o[3] = v[3] * bfhi(g.y);
                    o[4] = v[4] * bflo(g.z); o[5] = v[5] * bfhi(g.z); o[6] = v[6] * bflo(g.w); o[7] = v[7] * bfhi(g.w);
                    *(u32x4*)(T1 + (size_t)EPI_ROW4(mq) * 1024 + u.pn * 256 + EPI_CB(bj)) = pack8f(o);
                }
        }
    }
};
struct EpiGateB {
    static constexpr bool PERM = true, AFTER_DRAIN = false;
    unsigned char* ws;
    DI void operator()(const pg8::f32x4 (&acc)[2][2][4][2], const pg8::Unit& u, int wr, int wc, int fr_, int fq_) const {
        int fr = fr_, fq = fq_; asm volatile("" : "+v"(fr), "+v"(fq));
        const bf16_t* GT = (const bf16_t*)(ws + OFF_GT); const bf16_t* T1 = (const bf16_t*)(ws + OFF_T1); bf16_t* MR = (bf16_t*)(ws + OFF_MRG);
#pragma unroll
        for (int ai = 0; ai < 2; ++ai) {
            u32x4 gq[4][2], tq[4][2];
#pragma unroll
            for (int mq = 0; mq < 4; ++mq)
#pragma unroll
                for (int bj = 0; bj < 2; ++bj) { gq[mq][bj] = *(const u32x4*)(GT + (size_t)EPI_ROW4(mq) * 2048 + 1024 + u.pn * 256 + EPI_CB(bj));
                                                 tq[mq][bj] = *(const u32x4*)(T1 + (size_t)EPI_ROW4(mq) * 1024 + u.pn * 256 + EPI_CB(bj)); }
#pragma unroll
            for (int mq = 0; mq < 4; ++mq)
#pragma unroll
                for (int bj = 0; bj < 2; ++bj) {
                    EPI_V8M(mq, bj)
                    const u32x4 g = gq[mq][bj], t = tq[mq][bj];
                    float o[8];
                    o[0] = bflo(t.x) + v[0] * bflo(g.x); o[1] = bfhi(t.x) + v[1] * bfhi(g.x); o[2] = bflo(t.y) + v[2] * bflo(g.y); o[3] = bfhi(t.y) + v[3] * bfhi(g.y);
                    o[4] = bflo(t.z) + v[4] * bflo(g.z); o[5] = bfhi(t.z) + v[5] * bfhi(g.z); o[6] = bflo(t.w) + v[6] * bflo(g.w); o[7] = bfhi(t.w) + v[7] * bfhi(g.w);
                    *(u32x4*)(MR + (size_t)EPI_ROW4(mq) * 1024 + u.pn * 256 + EPI_CB(bj)) = pack8f(o);
                }
        }
    }
};
struct EpiB16 {
    static constexpr bool PERM = true, AFTER_DRAIN = false;
    bf16_t* D;
    DI void operator()(const pg8::f32x4 (&acc)[2][2][4][2], const pg8::Unit& u, int wr, int wc, int fr_, int fq_) const {
        int fr = fr_, fq = fq_; asm volatile("" : "+v"(fr), "+v"(fq));
        EPI_LOOP_BEGIN
            *(u32x4*)(D + (size_t)lr * 1024 + u.pn * 256 + cb) = pack8f(v);
        EPI_LOOP_END
    }
};
struct EpiG {
    static constexpr bool PERM = true, AFTER_DRAIN = false;
    unsigned char* ws; float* out; int g0;
    DI void operator()(const pg8::f32x4 (&acc)[2][2][4][2], const pg8::Unit& u, int wr, int wc, int fr_, int fq_) const {
        int fr = fr_, fq = fq_; asm volatile("" : "+v"(fr), "+v"(fq));
        bf16_t* GR = (bf16_t*)(ws + OFF_GR);
        EPI_LOOP_BEGIN
            const int col = u.pn * 256 + cb;
            *(u32x4*)(GR + (size_t)lr * DFF + col) = pack8f(v);
            if (!((g0 + u.pm * 256) >= PROWS || ((u.pm & 15) == 15))) continue;
            int b, t, smp; row_info(g0 + lr, b, t, smp);
            float* dst = nullptr;
            if (!smp) { if (t >= SEQ - 2) dst = out + OUT_FFN_P + (size_t)(b * 2 + (t - (SEQ - 2))) * DFF + col; }
            else { if (t >= 30) dst = out + OUT_FFN_S + (size_t)(b * 2 + (t - 30)) * DFF + col; }
            if (dst) { *(f32x4*)dst = (f32x4){v[0], v[1], v[2], v[3]}; *(f32x4*)(dst + 4) = (f32x4){v[4], v[5], v[6], v[7]}; }
        EPI_LOOP_END
    }
};
template <int K> DI u32x4 dpp_ror4(u32x4 v) {
    u32x4 r;
    r.x = (unsigned)__builtin_amdgcn_update_dpp(0, (int)v.x, 0x120 + K, 0xF, 0xF, false); r.y = (unsigned)__builtin_amdgcn_update_dpp(0, (int)v.y, 0x120 + K, 0xF, 0xF, false);
    r.z = (unsigned)__builtin_amdgcn_update_dpp(0, (int)v.z, 0x120 + K, 0xF, 0xF, false); r.w = (unsigned)__builtin_amdgcn_update_dpp(0, (int)v.w, 0x120 + K, 0xF, 0xF, false);
    return r;
}
struct EpiU {
    static constexpr bool PERM = true, AFTER_DRAIN = false;
    unsigned char* ws; const float* cw; const float* cbias; const float* ffn_ctx; int g0;
    DI void operator()(const pg8::f32x4 (&acc)[2][2][4][2], const pg8::Unit& u, int wr, int wc, int fr_, int fq_) const {
        int fr = fr_, fq = fq_; asm volatile("" : "+v"(fr), "+v"(fq));
        const bf16_t* GR = (const bf16_t*)(ws + OFF_GR); bf16_t* ACT = (bf16_t*)(ws + OFF_ACT);
#pragma unroll
        for (int bj = 0; bj < 2; ++bj) {
            const int col = u.pn * 256 + EPI_CB(bj);
            const f32x4 cb0 = *(const f32x4*)(cbias + col), cb1 = *(const f32x4*)(cbias + col + 4);
            const f32x4 w00 = *(const f32x4*)(cw + col), w01 = *(const f32x4*)(cw + col + 4), w10 = *(const f32x4*)(cw + DFF + col), w11 = *(const f32x4*)(cw + DFF + col + 4), w20 = *(const f32x4*)(cw + 2 * DFF + col), w21 = *(const f32x4*)(cw + 2 * DFF + col + 4);
            const float cbv[8] = {cb0[0], cb0[1], cb0[2], cb0[3], cb1[0], cb1[1], cb1[2], cb1[3]};
            const float w0v[8] = {w00[0], w00[1], w00[2], w00[3], w01[0], w01[1], w01[2], w01[3]};
            const float w1v[8] = {w10[0], w10[1], w10[2], w10[3], w11[0], w11[1], w11[2], w11[3]};
            const float w2v[8] = {w20[0], w20[1], w20[2], w20[3], w21[0], w21[1], w21[2], w21[3]};
#pragma unroll
            for (int ai = 0; ai < 2; ++ai) {
                const int rbase = u.pm * 256 + ai * 128 + wr * 64;
                u32x4 X[5];
                { const int rp = rbase - 16 + fr; X[0] = *(const u32x4*)(GR + (size_t)(rp >= 0 ? rp : 0) * DFF + col); }
#pragma unroll
                for (int mq = 0; mq < 4; ++mq) X[1 + mq] = *(const u32x4*)(GR + (size_t)(rbase + mq * 16 + fr) * DFF + col);
#pragma unroll
                for (int mq = 0; mq < 4; ++mq) {
                    const u32x4 cur = X[1 + mq], prv = X[mq];
                    const u32x4 r1c = dpp_ror4<1>(cur), r1p = dpp_ror4<1>(prv), r2c = dpp_ror4<2>(cur), r2p = dpp_ror4<2>(prv);
                    u32x4 q1, q0;
                    q1.x = fr >= 1 ? r1c.x : r1p.x; q1.y = fr >= 1 ? r1c.y : r1p.y; q1.z = fr >= 1 ? r1c.z : r1p.z; q1.w = fr >= 1 ? r1c.w : r1p.w;
                    q0.x = fr >= 2 ? r2c.x : r2p.x; q0.y = fr >= 2 ? r2c.y : r2p.y; q0.z = fr >= 2 ? r2c.z : r2p.z; q0.w = fr >= 2 ? r2c.w : r2p.w;
                    float v[8]; { const pg8::f32x4 a0 = acc[ai][bj][mq][0], a1 = acc[ai][bj][mq][1]; v[0] = a0[0]; v[1] = a0[1]; v[2] = a0[2]; v[3] = a0[3]; v[4] = a1[0]; v[5] = a1[1]; v[6] = a1[2]; v[7] = a1[3]; }
                    const int lr = rbase + mq * 16 + fr;
                    int b, t, smp; row_info(g0 + lr, b, t, smp);
                    float x0[8], x1[8], x2[8];
                    x2[0] = bflo(cur.x); x2[1] = bfhi(cur.x); x2[2] = bflo(cur.y); x2[3] = bfhi(cur.y); x2[4] = bflo(cur.z); x2[5] = bfhi(cur.z); x2[6] = bflo(cur.w); x2[7] = bfhi(cur.w);
                    x1[0] = bflo(q1.x); x1[1] = bfhi(q1.x); x1[2] = bflo(q1.y); x1[3] = bfhi(q1.y); x1[4] = bflo(q1.z); x1[5] = bfhi(q1.z); x1[6] = bflo(q1.w); x1[7] = bfhi(q1.w);
                    x0[0] = bflo(q0.x); x0[1] = bfhi(q0.x); x0[2] = bflo(q0.y); x0[3] = bfhi(q0.y); x0[4] = bflo(q0.z); x0[5] = bfhi(q0.z); x0[6] = bflo(q0.w); x0[7] = bfhi(q0.w);
                    if (t < 2) {
                        if (smp) { const float* c0 = ffn_ctx + (size_t)(b * 2 + t) * DFF + col; const float* c1 = ffn_ctx + (size_t)(b * 2 + 1) * DFF + col;
#pragma unroll
                            for (int e = 0; e < 8; ++e) { x0[e] = c0[e]; if (t < 1) x1[e] = c1[e]; } }
                        else {
#pragma unroll
                            for (int e = 0; e < 8; ++e) { x0[e] = 0.f; if (t < 1) x1[e] = 0.f; } }
                    }
                    float o[8];
#pragma unroll
                    for (int e = 0; e < 8; ++e) { const float gg = cbv[e] + w0v[e] * x0[e] + w1v[e] * x1[e] + w2v[e] * x2[e]; o[e] = silu_f(gg) * v[e]; }
                    *(u32x4*)(ACT + (size_t)lr * DFF + col) = pack8f(o);
                }
            }
        }
    }
};

DI void transpose_item(const float* W, int K, int N, bf16_t* WT, int dst_row0, LAS float* scr, int k0, int n0, int lane) {
#pragma unroll 8
    for (int i = 0; i < 32; ++i) { const int kk = 2 * i + (lane >> 5); scr[kk * 33 + (lane & 31)] = W[(size_t)(k0 + kk) * N + n0 + (lane & 31)]; }
    asm volatile("s_waitcnt lgkmcnt(0)" ::: "memory");
    const int c = lane & 7;
#pragma unroll
    for (int j = 0; j < 4; ++j) { const int n = (lane >> 3) + 8 * j; const LAS float* s = scr + (8 * c) * 33 + n;
        u32x4 o; o.x = pk2(s[0 * 33], s[1 * 33]); o.y = pk2(s[2 * 33], s[3 * 33]); o.z = pk2(s[4 * 33], s[5 * 33]); o.w = pk2(s[6 * 33], s[7 * 33]);
        *(u32x4*)(WT + (size_t)(dst_row0 + n) * K + k0 + 8 * c) = o; }
    asm volatile("s_waitcnt lgkmcnt(0)" ::: "memory");
}

DI void phase0(const Params& P, LAS unsigned char* lds) {
    int tid_l = threadIdx.x; asm volatile("" : "+v"(tid_l));
    const int tid = tid_l, lane = tid & 63, wid = tid >> 6;
    const int gw = blockIdx.x * 8 + wid, NGW = gridDim.x * 8;
    LAS float* scr = (LAS float*)(lds + wid * 16384);
    constexpr int I_IN = 16 * 305, I_SSM = 32 * 32, I_ATT = 16 * 32, I_OUT = 16 * 32, I_FIN = 16 * 176, I_FOUT = 44 * 32;
    constexpr int NITEMS = I_IN + I_SSM + I_ATT + I_OUT + I_FIN + I_FOUT;
    for (int it = gw; it < NITEMS; it += NGW) {
        int r = it;
        if (r < I_IN) { const int kb = r / 305, nb = r % 305, n0 = 32 * nb; const int d0 = n0 < 6144 ? n0 : (n0 == 6144 ? 9728 : n0 - 32);
            transpose_item(P.w_in, 1024, 9760, (bf16_t*)(P.ws + OFF_WIN), d0, scr, 64 * kb, n0, lane); continue; } r -= I_IN;
        if (r < I_SSM) { transpose_item(P.w_ssm_out, 2048, 1024, (bf16_t*)(P.ws + OFF_WSSM), 32 * (r % 32), scr, 64 * (r / 32), 32 * (r % 32), lane); continue; } r -= I_SSM;
        if (r < I_ATT) { transpose_item(P.w_att_out, 1024, 1024, (bf16_t*)(P.ws + OFF_WATT), 32 * (r % 32), scr, 64 * (r / 32), 32 * (r % 32), lane); continue; } r -= I_ATT;
        if (r < I_OUT) { transpose_item(P.w_out, 1024, 1024, (bf16_t*)(P.ws + OFF_WOUT), 32 * (r % 32), scr, 64 * (r / 32), 32 * (r % 32), lane); continue; } r -= I_OUT;
        if (r < I_FIN) { transpose_item(P.w_ffn_in, 1024, 5632, (bf16_t*)(P.ws + OFF_WFIN), 32 * (r % 176), scr, 64 * (r / 176), 32 * (r % 176), lane); continue; } r -= I_FIN;
        transpose_item(P.w_ffn_out, 2816, 1024, (bf16_t*)(P.ws + OFF_WFOUT), 32 * (r % 32), scr, 64 * (r / 32), 32 * (r % 32), lane);
    }
    { const size_t n16 = (size_t)224 * 1024 * 2 / 16; u32x4* p = (u32x4*)(P.ws + OFF_WIN + (size_t)9760 * 1024 * 2);
      for (size_t i = (size_t)blockIdx.x * 512 + tid; i < n16; i += (size_t)gridDim.x * 512) p[i] = (u32x4){0u, 0u, 0u, 0u}; }
    { float* tab = (float*)(P.ws + OFF_ROPE);
      for (int i = blockIdx.x * 512 + tid; i < 4128 * 16; i += gridDim.x * 512) {
          const int row = i >> 4, e = i & 15, f = e & 7; const int pos = row < 4096 ? row : 2048 + (row - 4096);
          const float inv = powf(500000.0f, -(float)f / 8.0f); const float ang = (float)pos * inv;
          tab[i] = e < 8 ? (float)cos((double)ang) : (float)sin((double)ang); } }
    { const int n4 = 16 * 96 * 256 / 4;
      for (int i = blockIdx.x * 512 + tid; i < 2 * n4; i += gridDim.x * 512) {
          const int which = i >= n4, j = which ? i - n4 : i; const int b = j / (96 * 64), rem = j % (96 * 64);
          const f32x4 v = *((const f32x4*)((which ? P.cache_v : P.cache_k) + (size_t)(b * 128 + 32) * 256) + rem);
          *((f32x4*)(P.out + (which ? OUT_V_S : OUT_K_S) + (size_t)b * 128 * 256) + rem) = v; } }
    __syncthreads();
    LAS float* sc = (LAS float*)lds;
    for (int chunk = blockIdx.x; chunk < 192; chunk += gridDim.x) {
        for (int i = tid; i < 32 * 1024; i += 512) { const int r = i >> 10, k = i & 1023; const float c = r < 16 ? P.c_prompt[r * 1024 + k] : P.c_sample[(r - 16) * 1024 + k]; sc[i] = silu_f(c); }
        __syncthreads();
        const int col = tid & 31, ks = tid >> 5, c0 = chunk * 32;
        float a[32];
#pragma unroll
        for (int r = 0; r < 32; ++r) a[r] = 0.f;
        for (int k = ks * 64; k < ks * 64 + 64; k += 4) {
            const float w0 = P.w_ada[(size_t)k * 6144 + c0 + col], w1 = P.w_ada[(size_t)(k + 1) * 6144 + c0 + col], w2 = P.w_ada[(size_t)(k + 2) * 6144 + c0 + col], w3 = P.w_ada[(size_t)(k + 3) * 6144 + c0 + col];
#pragma unroll
            for (int r = 0; r < 32; ++r) { const f32x4 s = *(const LAS f32x4*)(sc + r * 1024 + k); a[r] += s[0] * w0 + s[1] * w1 + s[2] * w2 + s[3] * w3; }
        }
        __syncthreads();
#pragma unroll
        for (int r = 0; r < 32; ++r) sc[(ks * 32 + r) * 32 + col] = a[r];
        __syncthreads();
        for (int o = tid; o < 1024; o += 512) { const int r = o >> 5, cc = o & 31; float s = P.b_ada[c0 + cc];
#pragma unroll
            for (int q = 0; q < 16; ++q) s += sc[(q * 32 + r) * 32 + cc];
            ((float*)(P.ws + OFF_MOD))[r * 6144 + c0 + cc] = s; }
        __syncthreads();
    }
}

DI const float* xrow_ptr(const Params& P, int grow) { return grow < PROWS ? P.x_prompt + (size_t)grow * DM : P.x_sample + (size_t)(grow - PROWS) * DM; }
DI int seq_of(int grow) { return grow < PROWS ? (grow >> 12) : 16 + ((grow - PROWS) >> 5); }

DI void rowpass1(const Params& P, int g0, int rows) {
    int tid_l = threadIdx.x; asm volatile("" : "+v"(tid_l));
    const int lane = tid_l & 63, gw = blockIdx.x * 8 + (tid_l >> 6), NGW = gridDim.x * 8;
    const float* mod = (const float*)(P.ws + OFF_MOD); bf16_t* HN = (bf16_t*)(P.ws + OFF_HN);
    f32x4 v[4], nv[4];
    if (gw < rows) { const float* xr = xrow_ptr(P, g0 + gw);
#pragma unroll
        for (int j = 0; j < 4; ++j) v[j] = __builtin_nontemporal_load((const f32x4*)(xr + 4 * lane + 256 * j)); }
    for (int lr = gw; lr < rows; lr += NGW) {
        const int grow = g0 + lr; const float* md = mod + (size_t)seq_of(grow) * 6144;
        if (lr + NGW < rows) { const float* xn = xrow_ptr(P, grow + NGW);
#pragma unroll
            for (int j = 0; j < 4; ++j) nv[j] = __builtin_nontemporal_load((const f32x4*)(xn + 4 * lane + 256 * j)); }
        float ss = 0.f;
#pragma unroll
        for (int j = 0; j < 4; ++j) ss += (v[j][0] * v[j][0] + v[j][1] * v[j][1]) + (v[j][2] * v[j][2] + v[j][3] * v[j][3]);
        const float r = rsqrtf(wave_sum(ss) * (1.f / DM) + EPS);
#pragma unroll
        for (int j = 0; j < 4; ++j) { const int c = 4 * lane + 256 * j;
            const f32x4 w = *(const f32x4*)(P.norm_mix_pre + c), sh = *(const f32x4*)(md + c), scl = *(const f32x4*)(md + 1024 + c);
            const f32x4 h = (v[j] * r) * w * (scl + 1.f) + sh;
            u32x2 o; o.x = pk2(h[0], h[1]); o.y = pk2(h[2], h[3]); *(u32x2*)(HN + (size_t)lr * DM + c) = o; }
#pragma unroll
        for (int j = 0; j < 4; ++j) v[j] = nv[j];
    }
}
DI void rowpass2(const Params& P, int g0, int rows) {
    int tid_l = threadIdx.x; asm volatile("" : "+v"(tid_l));
    const int lane = tid_l & 63, gw = blockIdx.x * 8 + (tid_l >> 6), NGW = gridDim.x * 8;
    const float* mod = (const float*)(P.ws + OFF_MOD); bf16_t* HN = (bf16_t*)(P.ws + OFF_HN); const bf16_t* O = (const bf16_t*)(P.ws + OFF_O);
    u32x2 oq[4], noq[4]; f32x4 x[4], nx[4];
    if (gw < rows) { const float* xr = xrow_ptr(P, g0 + gw);
#pragma unroll
        for (int j = 0; j < 4; ++j) { oq[j] = __builtin_nontemporal_load((const u32x2*)(O + (size_t)gw * DM + 4 * lane + 256 * j)); x[j] = __builtin_nontemporal_load((const f32x4*)(xr + 4 * lane + 256 * j)); } }
    for (int lr = gw; lr < rows; lr += NGW) {
        const int grow = g0 + lr; const float* md = mod + (size_t)seq_of(grow) * 6144; float* yr = P.out + (size_t)grow * DM;
        if (lr + NGW < rows) { const float* xn = xrow_ptr(P, grow + NGW);
#pragma unroll
            for (int j = 0; j < 4; ++j) { noq[j] = __builtin_nontemporal_load((const u32x2*)(O + (size_t)(lr + NGW) * DM + 4 * lane + 256 * j)); nx[j] = __builtin_nontemporal_load((const f32x4*)(xn + 4 * lane + 256 * j)); } }
        f32x4 o[4]; float ss = 0.f;
#pragma unroll
        for (int j = 0; j < 4; ++j) { o[j] = (f32x4){bflo(oq[j].x), bfhi(oq[j].x), bflo(oq[j].y), bfhi(oq[j].y)}; ss += (o[j][0] * o[j][0] + o[j][1] * o[j][1]) + (o[j][2] * o[j][2] + o[j][3] * o[j][3]); }
        const float r1 = rsqrtf(wave_sum(ss) * (1.f / DM) + EPS);
        f32x4 x1[4]; float ss2 = 0.f;
#pragma unroll
        for (int j = 0; j < 4; ++j) { const int c = 4 * lane + 256 * j;
            const f32x4 w = *(const f32x4*)(P.norm_mix_post + c), g1 = *(const f32x4*)(md + 2048 + c);
            x1[j] = x[j] + g1 * ((o[j] * r1) * w);
            __builtin_nontemporal_store(x1[j], (f32x4*)(yr + c));
            ss2 += (x1[j][0] * x1[j][0] + x1[j][1] * x1[j][1]) + (x1[j][2] * x1[j][2] + x1[j][3] * x1[j][3]); }
        const float r2 = rsqrtf(wave_sum(ss2) * (1.f / DM) + EPS);
#pragma unroll
        for (int j = 0; j < 4; ++j) { const int c = 4 * lane + 256 * j;
            const f32x4 w = *(const f32x4*)(P.norm_ffn_pre + c), sh = *(const f32x4*)(md + 3072 + c), scl = *(const f32x4*)(md + 4096 + c);
            const f32x4 h = (x1[j] * r2) * w * (scl + 1.f) + sh;
            u32x2 q; q.x = pk2(h[0], h[1]); q.y = pk2(h[2], h[3]); *(u32x2*)(HN + (size_t)lr * DM + c) = q; }
#pragma unroll
        for (int j = 0; j < 4; ++j) { oq[j] = noq[j]; x[j] = nx[j]; }
    }
}
DI void rowpass3(const Params& P, int g0, int rows) {
    int tid_l = threadIdx.x; asm volatile("" : "+v"(tid_l));
    const int lane = tid_l & 63, gw = blockIdx.x * 8 + (tid_l >> 6), NGW = gridDim.x * 8;
    const float* mod = (const float*)(P.ws + OFF_MOD); const bf16_t* F = (const bf16_t*)(P.ws + OFF_F);
    u32x2 fq[4], nfq[4]; f32x4 y[4], ny[4];
    if (gw < rows) { const float* yr = P.out + (size_t)(g0 + gw) * DM;
#pragma unroll
        for (int j = 0; j < 4; ++j) { fq[j] = __builtin_nontemporal_load((const u32x2*)(F + (size_t)gw * DM + 4 * lane + 256 * j)); y[j] = __builtin_nontemporal_load((const f32x4*)(yr + 4 * lane + 256 * j)); } }
    for (int lr = gw; lr < rows; lr += NGW) {
        const int grow = g0 + lr; const float* md = mod + (size_t)seq_of(grow) * 6144; float* yr = P.out + (size_t)grow * DM;
        if (lr + NGW < rows) { const float* yn = P.out + (size_t)(grow + NGW) * DM;
#pragma unroll
            for (int j = 0; j < 4; ++j) { nfq[j] = __builtin_nontemporal_load((const u32x2*)(F + (size_t)(lr + NGW) * DM + 4 * lane + 256 * j)); ny[j] = __builtin_nontemporal_load((const f32x4*)(yn + 4 * lane + 256 * j)); } }
        f32x4 f[4]; float ss = 0.f;
#pragma unroll
        for (int j = 0; j < 4; ++j) { f[j] = (f32x4){bflo(fq[j].x), bfhi(fq[j].x), bflo(fq[j].y), bfhi(fq[j].y)}; ss += (f[j][0] * f[j][0] + f[j][1] * f[j][1]) + (f[j][2] * f[j][2] + f[j][3] * f[j][3]); }
        const float r = rsqrtf(wave_sum(ss) * (1.f / DM) + EPS);
#pragma unroll
        for (int j = 0; j < 4; ++j) { const int c = 4 * lane + 256 * j;
            const f32x4 w = *(const f32x4*)(P.norm_ffn_post + c), g2 = *(const f32x4*)(md + 5120 + c);
            __builtin_nontemporal_store(y[j] + g2 * ((f[j] * r) * w), (f32x4*)(yr + c)); }
#pragma unroll
        for (int j = 0; j < 4; ++j) { fq[j] = nfq[j]; y[j] = ny[j]; }
    }
}

DI void conv_pass(const Params& P, int gi, int cu, int ncu) {
    int tid_l = threadIdx.x; asm volatile("" : "+v"(tid_l));
    const int col = tid_l * 8;
    bf16_t* X = (bf16_t*)(P.ws + OFF_XBC); const bf16_t* HALO = (const bf16_t*)(P.ws + OFF_HALO);
    float cw[4][8], cb[8];
#pragma unroll
    for (int j = 0; j < 4; ++j) { const f32x4 a = *(const f32x4*)(P.ssm_conv_w + j * 4096 + col), b2 = *(const f32x4*)(P.ssm_conv_w + j * 4096 + col + 4);
        cw[j][0] = a[0]; cw[j][1] = a[1]; cw[j][2] = a[2]; cw[j][3] = a[3]; cw[j][4] = b2[0]; cw[j][5] = b2[1]; cw[j][6] = b2[2]; cw[j][7] = b2[3]; }
    { const f32x4 a = *(const f32x4*)(P.ssm_conv_b + col), b2 = *(const f32x4*)(P.ssm_conv_b + col + 4);
      cb[0] = a[0]; cb[1] = a[1]; cb[2] = a[2]; cb[3] = a[3]; cb[4] = b2[0]; cb[5] = b2[1]; cb[6] = b2[2]; cb[7] = b2[3]; }
    const int nunits = 512 + (gi ? 16 : 0);
    for (int u = cu; u < nunits; u += ncu) {
        const bool smp = u >= 512;
        const int lr0 = smp ? 32768 + (u - 512) * 32 : u * 64, nb8 = smp ? 4 : 8;
        float p[3][8];
        if (smp) {
#pragma unroll
            for (int i = 0; i < 3; ++i) { const float* c = P.state_conv + (size_t)((u - 512) * 3 + i) * 4096 + col; const f32x4 a = *(const f32x4*)c, b2 = *(const f32x4*)(c + 4);
                p[i][0] = a[0]; p[i][1] = a[1]; p[i][2] = a[2]; p[i][3] = a[3]; p[i][4] = b2[0]; p[i][5] = b2[1]; p[i][6] = b2[2]; p[i][7] = b2[3]; }
        } else if ((lr0 & 4095) == 0) {
#pragma unroll
            for (int i = 0; i < 3; ++i)
#pragma unroll
                for (int e = 0; e < 8; ++e) p[i][e] = 0.f;
        } else {
#pragma unroll
            for (int i = 0; i < 3; ++i) { const u32x4 q = *(const u32x4*)(HALO + ((size_t)(u - 1) * 3 + i) * 4096 + col);
                p[i][0] = bflo(q.x); p[i][1] = bfhi(q.x); p[i][2] = bflo(q.y); p[i][3] = bfhi(q.y); p[i][4] = bflo(q.z); p[i][5] = bfhi(q.z); p[i][6] = bflo(q.w); p[i][7] = bfhi(q.w); }
        }
        bf16_t* xp = X + (size_t)lr0 * 4096 + col;
        u32x4 q[8], nq[8];
#pragma unroll
        for (int e = 0; e < 8; ++e) q[e] = __builtin_nontemporal_load((const u32x4*)(xp + (size_t)e * 4096));
        for (int l8 = 0; l8 < nb8; ++l8) {
            if (l8 + 1 < nb8) {
#pragma unroll
                for (int e = 0; e < 8; ++e) nq[e] = __builtin_nontemporal_load((const u32x4*)(xp + (size_t)((l8 + 1) * 8 + e) * 4096)); }
#pragma unroll
            for (int e = 0; e < 8; ++e) {
                float cur[8] = {bflo(q[e].x), bfhi(q[e].x), bflo(q[e].y), bfhi(q[e].y), bflo(q[e].z), bfhi(q[e].z), bflo(q[e].w), bfhi(q[e].w)};
                float o[8];
#pragma unroll
                for (int k = 0; k < 8; ++k) { o[k] = silu_f(cb[k] + cw[0][k] * p[0][k] + cw[1][k] * p[1][k] + cw[2][k] * p[2][k] + cw[3][k] * cur[k]); p[0][k] = p[1][k]; p[1][k] = p[2][k]; p[2][k] = cur[k]; }
                *(u32x4*)(xp + (size_t)(l8 * 8 + e) * 4096) = pack8f(o);
            }
#pragma unroll
            for (int e = 0; e < 8; ++e) q[e] = nq[e];
        }
    }
}

constexpr int SL_XT = 0, SL_BM = 36864, SL_CM = 54272, SL_BMT = 71680, SL_YT = 90112, SL_ARR = 122880;
template <int MODE>
DI void ssd_unit(const Params& P, LAS unsigned char* lds, int g0, int b, int g, int sample, int seg) {
    int tid_l = threadIdx.x; asm volatile("" : "+v"(tid_l));
    const int tid = tid_l, lane = tid & 63, wid = __builtin_amdgcn_readfirstlane(tid >> 6);
    const int lrow0 = sample ? (PROWS - g0) + b * 32 : (b * SEQ - g0);
    const int ck0 = sample ? 0 : seg * 16, nchunks = sample ? 1 : ck0 + 16, ntok = sample ? 32 : 64;
    const bf16_t* XBC = (const bf16_t*)(P.ws + OFF_XBC); const bf16_t* Zb = (const bf16_t*)(P.ws + OFF_Z); const float* DT = (const float*)(P.ws + OFF_DT); bf16_t* YS = (bf16_t*)(P.ws + OFF_YS);
    LAS unsigned char* XT = lds + SL_XT; LAS unsigned char* BM = lds + SL_BM; LAS unsigned char* CM = lds + SL_CM; LAS unsigned char* BMT = lds + SL_BMT; LAS unsigned char* YT = lds + SL_YT;
    LAS float* ARR = (LAS float*)(lds + SL_ARR);
    const int cp = tid & 255, th = __builtin_amdgcn_readfirstlane(tid >> 8), c0 = 2 * cp;
    const int colc = c0 < 256 ? g * 256 + c0 : (c0 < 384 ? 2048 + g * 128 + (c0 - 256) : 3072 + g * 128 + (c0 - 384));
    const float ldmask = (sample && th == 1) ? 0.f : 1.f;
    unsigned raw[32];
    const unsigned colc2 = (unsigned)colc * 2u;
#define SSD_ISSUE(CK) do { const char* ub_ = (const char*)XBC + (size_t)(lrow0 + (CK) * 64 + 32 * th) * 8192;     \
        _Pragma("unroll") for (int i = 0; i < 32; ++i) raw[i] = *(const unsigned*)(ub_ + (size_t)i * 8192 + colc2); } while (0)
    const int r = wid >> 1, hp = wid & 1, c31_0 = lane & 31, h_0 = lane >> 5;
    const float Dr = P.ssm_d[g * 4 + r];
    const LAS float* dtl = ARR + r * 64; const LAS float* acsr = ARR + 256 + r * 64; const LAS float* eacsr = ARR + 512 + r * 64; const LAS float* wscr = ARR + 768 + r * 64;
    float* stout = P.out + (sample ? OUT_SSM_S : OUT_SSM_P) + ((size_t)(b * 32 + g * 4 + r) * 64 + 32 * hp + c31_0) * 128;
    f32x16 HT[4];
#pragma unroll
    for (int nb = 0; nb < 4; ++nb)
#pragma unroll
        for (int i = 0; i < 16; ++i) HT[nb][i] = 0.f;
    if (sample) {
        const float* si = P.state_ssm + ((size_t)(b * 32 + g * 4 + r) * 64 + 32 * hp + c31_0) * 128;
#pragma unroll
        for (int nb = 0; nb < 4; ++nb)
#pragma unroll
            for (int i4 = 0; i4 < 4; ++i4) { const f32x4 q = *(const f32x4*)(si + 32 * nb + 8 * i4 + 4 * h_0); HT[nb][4 * i4] = q[0]; HT[nb][4 * i4 + 1] = q[1]; HT[nb][4 * i4 + 2] = q[2]; HT[nb][4 * i4 + 3] = q[3]; }
    }
    const size_t sidx = (size_t)(((b & 7) * 8 + g) * 3) * 4 + r;
    if (MODE == 1 && !sample && seg > 0) {
        const float* Fb = (const float*)(P.ws + OFF_SSF) + sidx * 8192 + (size_t)(32 * hp + c31_0) * 128; const float* Db = (const float*)(P.ws + OFF_SSDK) + sidx;
#pragma unroll
        for (int s = 0; s < 3; ++s) if (s < seg) {
            const float d = s == 0 ? 0.f : Db[4 * s];
#pragma unroll
            for (int nb = 0; nb < 4; ++nb)
#pragma unroll
                for (int i4 = 0; i4 < 4; ++i4) { const f32x4 q = *(const f32x4*)(Fb + (size_t)s * 4 * 8192 + 32 * nb + 8 * i4 + 4 * h_0);
                    HT[nb][4 * i4] = HT[nb][4 * i4] * d + q[0]; HT[nb][4 * i4 + 1] = HT[nb][4 * i4 + 1] * d + q[1]; HT[nb][4 * i4 + 2] = HT[nb][4 * i4 + 2] * d + q[2]; HT[nb][4 * i4 + 3] = HT[nb][4 * i4 + 3] * d + q[3]; }
        }
    }
    float ssum = 0.f;
    if (MODE == 1 || c0 < 384) SSD_ISSUE(ck0);
    float dtv_n = (wid < 4 && lane < ntok) ? DT[(size_t)(lrow0 + ck0 * 64 + lane) * 32 + g * 4 + wid] : 0.f;
    for (int ck = ck0; ck < nchunks; ++ck) {
        const int cb0 = lrow0 + ck * 64;
        const int boff = (MODE == 0) ? (ck & 1) * 59392 : 0;
        LAS unsigned char* XT = (MODE == 0) ? lds + boff : lds + SL_XT; LAS unsigned char* BMT = (MODE == 0) ? lds + boff + 36864 : lds + SL_BMT;
        LAS float* ARR = (MODE == 0) ? (LAS float*)(lds + boff + 55296) : (LAS float*)(lds + SL_ARR);
        const LAS float* dtl = ARR + r * 64; const LAS float* acsr = ARR + 256 + r * 64; const LAS float* eacsr = ARR + 512 + r * 64; const LAS float* wscr = ARR + 768 + r * 64;
        (void)dtl; (void)acsr;
        int c31 = c31_0, h = h_0, tidv = tid, cpv = cp; asm volatile("" : "+v"(c31), "+v"(h), "+v"(tidv), "+v"(cpv));
        if (wid < 4) {
            const int hidx = g * 4 + wid;
            const float dtv = dtv_n;
            const float Ar = -__expf(P.ssm_a_log[hidx]);
            float acs = dtv * Ar;
#pragma unroll
            for (int o = 1; o < 64; o <<= 1) { const float t = __shfl_up(acs, o); if (lane >= o) acs += t; }
            const float last = __shfl(acs, 63);
            ARR[wid * 64 + lane] = dtv; ARR[256 + wid * 64 + lane] = acs; ARR[512 + wid * 64 + lane] = __expf(acs); ARR[768 + wid * 64 + lane] = dtv * __expf(last - acs);
        }
        {
            const int c0v = 2 * cpv;
            unsigned pa[16], pb[16];
            unsigned pab[32];
            const unsigned msk = ldmask != 0.f ? 0xffffffffu : 0u;
#pragma unroll
            for (int e = 0; e < 32; ++e) pab[e] = raw[e] & msk;
#pragma unroll
            for (int e = 0; e < 32; e += 2) { pa[e >> 1] = __builtin_amdgcn_perm(pab[e + 1], pab[e], 0x05040100u); pb[e >> 1] = __builtin_amdgcn_perm(pab[e + 1], pab[e], 0x07060302u); }
            if (c0v < 256) {
#pragma unroll
                for (int k = 0; k < 4; ++k) { *(LAS u32x4*)(XT + c0v * 144 + th * 64 + k * 16) = (u32x4){pa[4 * k], pa[4 * k + 1], pa[4 * k + 2], pa[4 * k + 3]};
                                              *(LAS u32x4*)(XT + (c0v + 1) * 144 + th * 64 + k * 16) = (u32x4){pb[4 * k], pb[4 * k + 1], pb[4 * k + 2], pb[4 * k + 3]}; }
            } else if (c0v < 384) {
                const int n = c0v - 256;
#pragma unroll
                for (int k = 0; k < 4; ++k) { *(LAS u32x4*)(BMT + n * 144 + th * 64 + k * 16) = (u32x4){pa[4 * k], pa[4 * k + 1], pa[4 * k + 2], pa[4 * k + 3]};
                                              *(LAS u32x4*)(BMT + (n + 1) * 144 + th * 64 + k * 16) = (u32x4){pb[4 * k], pb[4 * k + 1], pb[4 * k + 2], pb[4 * k + 3]}; }
                if (MODE == 1) {
#pragma unroll
                for (int e = 0; e < 32; ++e) *(LAS unsigned*)(BM + (32 * th + e) * 272 + n * 2) = pab[e]; }
            } else if (MODE == 1) {
                const int n = c0v - 384;
#pragma unroll
                for (int e = 0; e < 32; ++e) *(LAS unsigned*)(CM + (32 * th + e) * 272 + n * 2) = pab[e];
            }
        }
        __syncthreads();
        const int nl = tidv >> 3, seg8 = tidv & 7; u32x4 zq[4];
        if (MODE == 1) {
        f32x16 Y[2];
#pragma unroll
        for (int lb = 0; lb < 2; ++lb) {
#pragma unroll
            for (int i = 0; i < 16; ++i) Y[lb][i] = 0.f;
            const int l = 32 * lb + c31; const float acs_l = acsr[l];
#pragma unroll
            for (int sb = 0; sb <= lb; ++sb) {
                f32x16 G;
#pragma unroll
                for (int i = 0; i < 16; ++i) G[i] = 0.f;
#pragma unroll
                for (int kh2 = 0; kh2 < 4; ++kh2) {
                    bf16x8 fa[2], fb[2];
#pragma unroll
                    for (int q = 0; q < 2; ++q) { const int ks = 2 * kh2 + q;
                        fa[q] = *(const LAS bf16x8*)(BM + (32 * sb + c31) * 272 + ks * 32 + h * 16);
                        fb[q] = *(const LAS bf16x8*)(CM + (32 * lb + c31) * 272 + ks * 32 + h * 16); }
#pragma unroll
                    for (int q = 0; q < 2; ++q) G = MFMA32(fa[q], fb[q], G);
                }
                bf16x8 Bx[2];
#pragma unroll
                for (int st = 0; st < 2; ++st) Bx[st] = ld2x8(XT + (r * 64 + 32 * hp + c31) * 144 + (32 * sb + 16 * st + 4 * h) * 2);
#pragma unroll
                for (int i4 = 0; i4 < 4; ++i4) {
                    const int s0 = 32 * sb + 8 * i4 + 4 * h;
                    const f32x4 as4 = *(const LAS f32x4*)(acsr + s0), ds4 = *(const LAS f32x4*)(dtl + s0);
#pragma unroll
                    for (int j = 0; j < 4; ++j) { const int s = s0 + j; const float arg = fminf(acs_l - as4[j], 0.f);
                        float val = G[4 * i4 + j] * __expf(arg) * ds4[j]; val = s <= l ? val : 0.f; if (s == l) val += Dr; G[4 * i4 + j] = val; }
                }
#pragma unroll
                for (int st = 0; st < 2; ++st) { const bf16x8 A = PACK8(G, st); Y[lb] = MFMA32(A, Bx[st], Y[lb]); }
            }
        }
        if (nl < ntok) {
#pragma unroll
            for (int k = 0; k < 4; ++k) zq[k] = *(const u32x4*)(Zb + (size_t)(cb0 + nl) * 2048 + g * 256 + seg8 * 32 + 8 * k);
        } else {
#pragma unroll
            for (int k = 0; k < 4; ++k) zq[k] = (u32x4){0u, 0u, 0u, 0u};
        }
        __builtin_amdgcn_sched_barrier(0);
        {
            f32x16 T[2];
#pragma unroll
            for (int lb = 0; lb < 2; ++lb)
#pragma unroll
                for (int i = 0; i < 16; ++i) T[lb][i] = 0.f;
#pragma unroll
            for (int nb = 0; nb < 4; ++nb) {
                bf16x8 A[2][2];
#pragma unroll
                for (int st = 0; st < 2; ++st)
#pragma unroll
                    for (int lb = 0; lb < 2; ++lb) A[st][lb] = ld2x8(CM + (32 * lb + c31) * 272 + (32 * nb + 16 * st + 4 * h) * 2);
#pragma unroll
                for (int st = 0; st < 2; ++st) {
                    const bf16x8 HF = PACK8(HT[nb], st);
#pragma unroll
                    for (int lb = 0; lb < 2; ++lb) T[lb] = MFMA32(A[st][lb], HF, T[lb]);
                }
            }
#pragma unroll
            for (int lb = 0; lb < 2; ++lb)
#pragma unroll
                for (int i4 = 0; i4 < 4; ++i4) { const f32x4 e4 = *(const LAS f32x4*)(eacsr + 32 * lb + 8 * i4 + 4 * h);
#pragma unroll
                    for (int j = 0; j < 4; ++j) Y[lb][4 * i4 + j] += e4[j] * T[lb][4 * i4 + j]; }
        }
#pragma unroll
        for (int lb = 0; lb < 2; ++lb)
#pragma unroll
            for (int i4 = 0; i4 < 4; ++i4)
#pragma unroll
                for (int j = 0; j < 4; ++j) {
                    const int lc = 32 * lb + 8 * i4 + j, ch = r * 64 + 32 * hp + c31;
                    *(LAS bf16_t*)(YT + (4 * h * 512 + ch * 2) + lc * 512) = f2bf(Y[lb][4 * i4 + j]);
                }
        }
        if (ck + 1 < nchunks) {
            if (MODE == 1 || c0 < 384) SSD_ISSUE(ck + 1);
            if (wid < 4 && lane < ntok) dtv_n = DT[(size_t)(cb0 + 64 + lane) * 32 + g * 4 + wid];
        }
        __builtin_amdgcn_sched_barrier(0);
        {
            const float ea = eacsr[63]; ssum += acsr[63];
#pragma unroll
            for (int nb = 0; nb < 4; ++nb)
#pragma unroll
                for (int i = 0; i < 16; ++i) HT[nb][i] *= ea;
#pragma unroll
            for (int st = 0; st < 4; ++st) {
                const u32x4 rawx = *(const LAS u32x4*)(XT + (r * 64 + 32 * hp + c31) * 144 + st * 32 + h * 16);
                const f32x4 w0 = *(const LAS f32x4*)(wscr + 16 * st + 8 * h), w1 = *(const LAS f32x4*)(wscr + 16 * st + 8 * h + 4);
                bf16x8 A[4];
#pragma unroll
                for (int nb = 0; nb < 4; ++nb) A[nb] = *(const LAS bf16x8*)(BMT + (32 * nb + c31) * 144 + st * 32 + h * 16);
                u32x4 sc; sc.x = pk2(bflo(rawx.x) * w0[0], bfhi(rawx.x) * w0[1]); sc.y = pk2(bflo(rawx.y) * w0[2], bfhi(rawx.y) * w0[3]);
                sc.z = pk2(bflo(rawx.z) * w1[0], bfhi(rawx.z) * w1[1]); sc.w = pk2(bflo(rawx.w) * w1[2], bfhi(rawx.w) * w1[3]);
                const bf16x8 Bf = __builtin_bit_cast(bf16x8, sc);
#pragma unroll
                for (int nb = 0; nb < 4; ++nb) HT[nb] = MFMA32(A[nb], Bf, HT[nb]);
            }
        }
        if (MODE == 1) __syncthreads();
        if (MODE == 1)
        {
            float v[32]; float ss = 0.f;
#pragma unroll
            for (int k = 0; k < 4; ++k) { const u32x4 q = *(const LAS u32x4*)(YT + nl * 512 + seg8 * 64 + k * 16);
                v[8 * k] = bflo(q.x) * bflo(zq[k].x); v[8 * k + 1] = bfhi(q.x) * bfhi(zq[k].x); v[8 * k + 2] = bflo(q.y) * bflo(zq[k].y); v[8 * k + 3] = bfhi(q.y) * bfhi(zq[k].y);
                v[8 * k + 4] = bflo(q.z) * bflo(zq[k].z); v[8 * k + 5] = bfhi(q.z) * bfhi(zq[k].z); v[8 * k + 6] = bflo(q.w) * bflo(zq[k].w); v[8 * k + 7] = bfhi(q.w) * bfhi(zq[k].w); }
#pragma unroll
            for (int e = 0; e < 32; ++e) ss += v[e] * v[e];
            ss += __shfl_xor(ss, 1); ss += __shfl_xor(ss, 2); ss += __shfl_xor(ss, 4);
            const float rstd = rsqrtf(ss * (1.f / 256.f) + EPS);
            if (nl < ntok) {
                const float* nw = P.ssm_norm + g * 256 + seg8 * 32; bf16_t* dst = YS + (size_t)(cb0 + nl) * 2048 + g * 256 + seg8 * 32;
#pragma unroll
                for (int k = 0; k < 4; ++k) { float o[8];
#pragma unroll
                    for (int e = 0; e < 8; ++e) o[e] = v[8 * k + e] * rstd * nw[8 * k + e];
                    *(u32x4*)(dst + 8 * k) = pack8f(o); }
            }
        }
    }
#undef SSD_ISSUE
    if (MODE == 0) {
        float* Fo = (float*)(P.ws + OFF_SSF) + (sidx + 4 * seg) * 8192 + (size_t)(32 * hp + c31_0) * 128;
#pragma unroll
        for (int nb = 0; nb < 4; ++nb)
#pragma unroll
            for (int i4 = 0; i4 < 4; ++i4) *(f32x4*)(Fo + 32 * nb + 8 * i4 + 4 * h_0) = (f32x4){HT[nb][4 * i4], HT[nb][4 * i4 + 1], HT[nb][4 * i4 + 2], HT[nb][4 * i4 + 3]};
        if (hp == 0 && lane == 0) ((float*)(P.ws + OFF_SSDK))[sidx + 4 * seg] = __expf(ssum);
    } else if (sample || seg == 3) {
#pragma unroll
        for (int nb = 0; nb < 4; ++nb)
#pragma unroll
            for (int i4 = 0; i4 < 4; ++i4) *(f32x4*)(stout + 32 * nb + 8 * i4 + 4 * h_0) = (f32x4){HT[nb][4 * i4], HT[nb][4 * i4 + 1], HT[nb][4 * i4 + 2], HT[nb][4 * i4 + 3]};
    }
    __syncthreads();
}

constexpr int AL_K = 0, AL_V = 27648, AL_O = AL_V + 64 * 392;
DI void attn_range(const Params& P, LAS unsigned char* lds, int g0, int gi, int u0, int u1, int ustep) {
    if (u0 >= u1) return;
    int tid_l = threadIdx.x; asm volatile("" : "+v"(tid_l));
    const int tid = tid_l, lane = tid & 63, wid = __builtin_amdgcn_readfirstlane(tid >> 6), c31 = lane & 31, h = lane >> 5;
    const bf16_t* Qb = (const bf16_t*)(P.ws + OFF_Q); const bf16_t* Kb = (const bf16_t*)(P.ws + OFF_K); const bf16_t* Vb = (const bf16_t*)(P.ws + OFF_V);
    bf16_t* YA = (bf16_t*)(P.ws + OFF_Q);
    LAS unsigned char* KT = lds + AL_K; LAS unsigned char* VT = lds + AL_V; LAS unsigned char* OS = lds + AL_O + wid * 4096;
    u32x4 kk[3], vv[3]; bf16x8 Bn[4];
#define ATT_ISSUE(UN) do { const int b_ = gi * 8 + ((UN) >> 8), c_ = ((UN) >> 2) & 63, kh_ = (UN) & 3; const int cs_ = c_ >= 2 ? c_ - 2 : 0, nk_ = (c_ - cs_ + 1) * 64; \
        const int kr_ = b_ * SEQ - g0 + cs_ * 64, qr_ = b_ * SEQ - g0 + c_ * 64; \
        _Pragma("unroll") for (int it = 0; it < 3; ++it) { const int idx = tid + it * 512, key = idx >> 3, d8 = (idx & 7) * 8, keyc = key < nk_ ? key : nk_ - 1; \
            kk[it] = *(const u32x4*)(Kb + (size_t)(kr_ + keyc) * 256 + kh_ * 64 + d8); vv[it] = *(const u32x4*)(Vb + (size_t)(kr_ + keyc) * 256 + kh_ * 64 + d8); } \
        { const int hq_ = kh_ * 4 + (wid >> 1), lrq_ = qr_ + (wid & 1) * 32 + c31; \
          _Pragma("unroll") for (int st = 0; st < 4; ++st) Bn[st] = *(const bf16x8*)(Qb + (size_t)lrq_ * 1024 + hq_ * 64 + 16 * st + 8 * h); } } while (0)
    if (u0 < 2048) ATT_ISSUE(u0);
    for (int u = u0; u < u1; u += ustep) {
        const int sample = u >= 2048, uu = sample ? u - 2048 : u;
        const int b = sample ? (uu >> 2) : gi * 8 + (uu >> 8), c = sample ? 0 : ((uu >> 2) & 63), kh = uu & 3;
        int nkeys, krow0 = 0, qrow0;
        if (!sample) { const int cs = c >= 2 ? c - 2 : 0; nkeys = (c - cs + 1) * 64; krow0 = b * SEQ - g0 + cs * 64; qrow0 = b * SEQ - g0 + c * 64; }
        else { nkeys = 160; qrow0 = PROWS - g0 + b * 32; }
        const int nkb = nkeys >> 5;
        const int rq = sample ? (wid & 3) : (wid >> 1), qh = sample ? 0 : (wid & 1);
        const int hq = kh * 4 + rq, lrq = qrow0 + qh * 32 + c31;
        bf16x8 Bq[4];
        if (!sample) {
#pragma unroll
            for (int it = 0; it < 3; ++it) { const int idx = tid + it * 512, key = idx >> 3, d8 = (idx & 7) * 8;
                if (key < nkeys) {
                    *(LAS u32x4*)(KT + key * 144 + d8 * 2) = kk[it];
#pragma unroll
                    for (int e = 0; e < 8; ++e) *(LAS bf16_t*)(VT + (d8 + e) * 392 + key * 2) = (bf16_t)((vv[it][e >> 1] >> (16 * (e & 1))) & 0xffffu);
                } }
#pragma unroll
            for (int st = 0; st < 4; ++st) Bq[st] = Bn[st];
        } else {
#pragma unroll
            for (int st = 0; st < 4; ++st) Bq[st] = *(const bf16x8*)(Qb + (size_t)lrq * 1024 + hq * 64 + 16 * st + 8 * h);
            for (int idx = tid; idx < nkeys * 8; idx += 512) {
                const int key = idx >> 3, d8 = (idx & 7) * 8;
                u32x4 k1, v1;
                if (key < 128) {
                    const float* ck = P.cache_k + ((size_t)(b * 128 + key) * 4 + kh) * 64 + d8; const float* cv = P.cache_v + ((size_t)(b * 128 + key) * 4 + kh) * 64 + d8;
                    const f32x4 a0 = *(const f32x4*)ck, a1 = *(const f32x4*)(ck + 4), b0 = *(const f32x4*)cv, b1 = *(const f32x4*)(cv + 4);
                    k1.x = pk2(a0[0], a0[1]); k1.y = pk2(a0[2], a0[3]); k1.z = pk2(a1[0], a1[1]); k1.w = pk2(a1[2], a1[3]);
                    v1.x = pk2(b0[0], b0[1]); v1.y = pk2(b0[2], b0[3]); v1.z = pk2(b1[0], b1[1]); v1.w = pk2(b1[2], b1[3]);
                } else {
                    const int lrk = qrow0 + (key - 128);
                    k1 = *(const u32x4*)(Kb + (size_t)lrk * 256 + kh * 64 + d8); v1 = *(const u32x4*)(Vb + (size_t)lrk * 256 + kh * 64 + d8);
                }
                *(LAS u32x4*)(KT + key * 144 + d8 * 2) = k1;
#pragma unroll
                for (int e = 0; e < 8; ++e) *(LAS bf16_t*)(VT + (d8 + e) * 392 + key * 2) = (bf16_t)((v1[e >> 1] >> (16 * (e & 1))) & 0xffffu);
            }
        }
        __syncthreads();
        { const int un = u + ustep; if (un < u1 && un < 2048) ATT_ISSUE(un); }
        const bool active = sample ? (wid < 4) : true;
        if (active) {
            f32x16 S[6];
#pragma unroll
            for (int kb = 0; kb < 6; ++kb) {
#pragma unroll
                for (int i = 0; i < 16; ++i) S[kb][i] = 0.f;
                if (kb < nkb) {
#pragma unroll
                    for (int st = 0; st < 4; ++st) { const bf16x8 A = *(const LAS bf16x8*)(KT + (32 * kb + c31) * 144 + st * 32 + h * 16); S[kb] = MFMA32(A, Bq[st], S[kb]); }
                }
            }
            const float sink = P.attn_sinks[hq];
            float m = sink;
#pragma unroll
            for (int kb = 0; kb < 6; ++kb) if (kb < nkb) {
#pragma unroll
                for (int i = 0; i < 16; ++i) m = fmaxf(m, S[kb][i]); }
            m = fmaxf(m, __shfl_xor(m, 32));
            float sum = 0.f;
#pragma unroll
            for (int kb = 0; kb < 6; ++kb) if (kb < nkb) {
#pragma unroll
                for (int i = 0; i < 16; ++i) { const float e = __expf(S[kb][i] - m); S[kb][i] = e; sum += e; } }
            sum += __shfl_xor(sum, 32);
            const float inv = 1.f / (sum + __expf(sink - m));
            f32x16 O[2];
#pragma unroll
            for (int db = 0; db < 2; ++db)
#pragma unroll
                for (int i = 0; i < 16; ++i) O[db][i] = 0.f;
#pragma unroll
            for (int kb = 0; kb < 6; ++kb) if (kb < nkb) {
#pragma unroll
                for (int i = 0; i < 16; ++i) S[kb][i] *= inv;
#pragma unroll
                for (int st = 0; st < 2; ++st) {
                    const bf16x8 A = PACK8(S[kb], st);
#pragma unroll
                    for (int db = 0; db < 2; ++db) { const bf16x8 Bv = ld2x8(VT + (32 * db + c31) * 392 + (32 * kb + 16 * st + 4 * h) * 2); O[db] = MFMA32(A, Bv, O[db]); }
                }
            }
#pragma unroll
            for (int db = 0; db < 2; ++db)
#pragma unroll
                for (int i4 = 0; i4 < 4; ++i4)
#pragma unroll
                    for (int j = 0; j < 4; ++j) *(LAS bf16_t*)(OS + (8 * i4 + 4 * h + j) * 128 + (32 * db + c31) * 2) = f2bf(O[db][4 * i4 + j]);
            asm volatile("s_waitcnt lgkmcnt(0)" ::: "memory");
#pragma unroll
            for (int it = 0; it < 4; ++it) { const int row = it * 8 + (lane >> 3), ch = lane & 7;
                const u32x4 v = *(const LAS u32x4*)(OS + row * 128 + ch * 16);
                *(u32x4*)(YA + (size_t)(qrow0 + qh * 32 + row) * 1024 + hq * 64 + ch * 8) = v; }
        }
        __syncthreads();
    }
#undef ATT_ISSUE
}

#define XB_TMO      128
#define XB_XCNT(j)  (256  + 64 * (j))
#define XB_XSUB(j)  (1280 + 64 * (j))
#define XB_XGEN(j)  (2304 + 64 * (j))
#define XB_TOP      3328
#define XB_TOPGEN   3392
#define XCD_BAR_WORDS 3456
#define XB_SPIN_CAP (1u << 18)

__device__ __forceinline__ unsigned xb_ld(unsigned* p)              { return __hip_atomic_load(p, __ATOMIC_RELAXED, __HIP_MEMORY_SCOPE_AGENT); }
__device__ __forceinline__ unsigned xb_add(unsigned* p, unsigned v) { return __hip_atomic_fetch_add(p, v, __ATOMIC_RELAXED, __HIP_MEMORY_SCOPE_AGENT); }
__device__ __forceinline__ unsigned xb_xcc_id() { return (unsigned)__builtin_amdgcn_s_getreg((3 << 11) | 20) & 0xFu; }
#define XB_SPIN(cond, bar) do { unsigned _sp = 0; while (cond) { __builtin_amdgcn_s_sleep(1); \
    if ((++_sp & 255u) == 0u) { if (xb_ld(&(bar)[XB_TMO])) break; if (_sp > XB_SPIN_CAP) { atomicAdd(&(bar)[XB_TMO], 1u); break; } } } } while (0)

struct XcdBarrier {
    unsigned* bar; unsigned x;
    volatile LAS unsigned* st;
};

__device__ __forceinline__ XcdBarrier xcd_barrier_post(unsigned* bar, volatile LAS unsigned* st) {
    XcdBarrier b; b.bar = bar; b.x = xb_xcc_id(); b.st = st;
    if (threadIdx.x == 0) (void)xb_add(&bar[XB_XCNT(b.x)], 1u);
    return b;
}
__device__ __forceinline__ void xcd_barrier_complete(unsigned* bar, unsigned x, unsigned& nloc, unsigned& nx) {
    const unsigned G = gridDim.x * gridDim.y * gridDim.z;
    unsigned sum, cnt, mine, sp = 0u;
    for (;;) {
        sum = 0u; cnt = 0u; mine = 0u;
#pragma unroll
        for (unsigned j = 0; j < 16; ++j) { const unsigned c = xb_ld(&bar[XB_XCNT(j)]); sum += c; cnt += (c > 0u) ? 1u : 0u; mine = (j == x) ? c : mine; }
        if (sum == G) break;
        __builtin_amdgcn_s_sleep(1);
        if ((++sp & 255u) == 0u) { if (xb_ld(&bar[XB_TMO])) break; if (sp > XB_SPIN_CAP) { atomicAdd(&bar[XB_TMO], 1u); break; } }
    }
    nloc = mine > 0u ? mine : 1u; nx = cnt > 0u ? cnt : 1u;
}

__device__ __forceinline__ void xcd_barrier(const XcdBarrier& b) {
    asm volatile("s_waitcnt vmcnt(0)" ::: "memory");
    __syncthreads();
    if (threadIdx.x == 0) {
        unsigned* bar = b.bar;
        __builtin_amdgcn_s_waitcnt(0);
        unsigned nloc = b.st[0], nx = b.st[1];
        if (nloc == 0u) { xcd_barrier_complete(bar, b.x, nloc, nx); b.st[0] = nloc; b.st[1] = nx; }
        const unsigned old = xb_add(&bar[XB_XSUB(b.x)], 1u);
        const unsigned gen = old / nloc;
        if (old + 1u == (gen + 1u) * nloc) {
            __builtin_amdgcn_fence(__ATOMIC_RELEASE, "agent");
            asm volatile("s_waitcnt vmcnt(0)" ::: "memory");
            const unsigned og = xb_add(&bar[XB_TOP], 1u);
            const unsigned tg = og / nx;
            if (og + 1u == (tg + 1u) * nx) xb_add(&bar[XB_TOPGEN], 1u);
            else XB_SPIN(xb_ld(&bar[XB_TOPGEN]) == tg, bar);
            __builtin_amdgcn_fence(__ATOMIC_ACQUIRE, "agent");
            xb_add(&bar[XB_XGEN(b.x)], 1u);
            asm volatile("s_waitcnt vmcnt(0)" ::: "memory");
        } else {
            XB_SPIN(xb_ld(&bar[XB_XGEN(b.x)]) == gen, bar);
            __builtin_amdgcn_fence(__ATOMIC_ACQUIRE, "agent");
            asm volatile("s_waitcnt vmcnt(0)" ::: "memory");
        }
    }
    __syncthreads();
}

#ifndef DUP_GEMM
#define DUP_GEMM 1
#endif
#ifndef DUPG0
#define DUPG0 DUP_GEMM
#endif
#ifndef DUPG1
#define DUPG1 DUP_GEMM
#endif
#ifndef DUPG2
#define DUPG2 DUP_GEMM
#endif
#ifndef DUPG3
#define DUPG3 DUP_GEMM
#endif
#ifndef DUPG4
#define DUPG4 DUP_GEMM
#endif
#ifndef DUPG5
#define DUPG5 DUP_GEMM
#endif
#ifndef DUPG6
#define DUPG6 DUP_GEMM
#endif
#ifndef FFN_WGM
#define FFN_WGM 4
#endif
#ifndef PROJ_ALIGN
#define PROJ_ALIGN true
#endif
#ifndef PROJ_WGM
#define PROJ_WGM 4
#endif
#ifndef DUP_SYNC
#define DUP_SYNC 1
#endif
#define GSYNC() do { for (int rs_ = 0; rs_ < DUP_SYNC; ++rs_) xcd_barrier(xbar); } while (0)
__global__ void __launch_bounds__(512, 2) fwd_megakernel(Params P) {
    extern __shared__ __attribute__((aligned(16))) unsigned char lds_raw[];
    LAS unsigned char* lds = (LAS unsigned char*)lds_raw;
    cg::grid_group grid = cg::this_grid();
    const int G = gridDim.x, bid = blockIdx.x;

    if (threadIdx.x < 64) ((volatile LAS unsigned*)(lds + 131072))[threadIdx.x] = 0u;
    if (bid == 0) for (int i = threadIdx.x; i < 4096; i += 512) ((unsigned*)(P.ws + OFF_BAR))[i] = 0u;
    __syncthreads();
    phase0(P, lds);
    grid.sync();
    XcdBarrier xbar = xcd_barrier_post((unsigned*)(P.ws + OFF_BAR), (volatile LAS unsigned*)(lds + 131072) + 8);

    for (int gi = 0; gi < 2; ++gi) {
        const int g0 = gi ? G_BASE1 : 0, rows = gi ? RG : 32768;
        rowpass1(P, g0, rows);
        GSYNC();
        for (int rep = 0; rep < DUPG0; ++rep)
        { pg8::Gemm g{(const bf16_t*)(P.ws + OFF_HN), (const bf16_t*)(P.ws + OFF_WIN), rows, NPROJ, 1024}; pg8::StaticOrder S; S.init(rows, NPROJ, G, bid); S.wgm = PROJ_WGM;
          EpiProj E{P.ws, P.out, P.ssm_dt_bias, g0};
          pg8::gemm_phase<EpiProj, pg8::StaticOrder, PROJ_ALIGN, true>(lds, g, S, E); }
        GSYNC();
        {
            constexpr int NCONV = 132, A0 = 1664;
            const int natt = 2048 + (gi ? 64 : 0);
            for (int stage = 0; stage < 3; ++stage) {
                if (stage == 0) { if (bid < NCONV) conv_pass(P, gi, bid, NCONV); }
                else if (stage == 1) { for (int u = bid; u < 192; u += G) ssd_unit<0>(P, lds, g0, gi * 8 + u / 24, (u / 3) & 7, 0, u % 3); }
                else {
                    const int nss = (gi == 1 && bid < 128) ? 2 : 1;
                    for (int k = 0; k < nss; ++k) {
                        if (k == 0 && bid >= 256) continue;
                        ssd_unit<1>(P, lds, g0, k ? (bid >> 3) : gi * 8 + (bid >> 5), k ? (bid & 7) : ((bid >> 2) & 7), k, bid & 3); }
                }
                int u0 = natt, u1 = natt, ustep = 1;
                if (stage == 0 && bid >= NCONV) { u0 = bid - NCONV; u1 = A0; ustep = G - NCONV; }
                if (stage == 1 && bid >= 192) { u0 = A0 + (bid - 192); u1 = natt; ustep = G - 192; }
                attn_range(P, lds, g0, gi, u0, u1, ustep);
                if (stage < 2) GSYNC();
            }
        }
        GSYNC();
        for (int rep = 0; rep < DUPG1; ++rep)
        { pg8::Gemm g{(const bf16_t*)(P.ws + OFF_YS), (const bf16_t*)(P.ws + OFF_WSSM), rows, 1024, 2048}; pg8::StaticOrder S; S.init(rows, 1024, G, bid);
          EpiGateA E{P.ws};
          pg8::gemm_phase<EpiGateA, pg8::StaticOrder, true, true>(lds, g, S, E); }
        __syncthreads();
        for (int rep = 0; rep < DUPG2; ++rep)
        { pg8::Gemm g{(const bf16_t*)(P.ws + OFF_Q), (const bf16_t*)(P.ws + OFF_WATT), rows, 1024, 1024}; pg8::StaticOrder S; S.init(rows, 1024, G, bid);
          EpiGateB E{P.ws};
          pg8::gemm_phase<EpiGateB, pg8::StaticOrder, true, true>(lds, g, S, E); }
        GSYNC();
        for (int rep = 0; rep < DUPG3; ++rep)
        { pg8::Gemm g{(const bf16_t*)(P.ws + OFF_MRG), (const bf16_t*)(P.ws + OFF_WOUT), rows, 1024, 1024}; pg8::StaticOrder S; S.init(rows, 1024, G, bid);
          EpiB16 E{(bf16_t*)(P.ws + OFF_O)};
          pg8::gemm_phase<EpiB16, pg8::StaticOrder, true, true>(lds, g, S, E); }
        GSYNC();
        rowpass2(P, g0, rows);
        GSYNC();
        for (int rep = 0; rep < DUPG4; ++rep)
        { pg8::Gemm g{(const bf16_t*)(P.ws + OFF_HN), (const bf16_t*)(P.ws + OFF_WFIN), rows, DFF, 1024}; pg8::StaticOrder S; S.init(rows, DFF, G, bid); S.wgm = FFN_WGM;
          EpiG E{P.ws, P.out, g0};
          pg8::gemm_phase<EpiG, pg8::StaticOrder, true, true>(lds, g, S, E); }
        GSYNC();
        for (int rep = 0; rep < DUPG5; ++rep)
        { pg8::Gemm g{(const bf16_t*)(P.ws + OFF_HN), (const bf16_t*)(P.ws + OFF_WFIN) + (size_t)DFF * 1024, rows, DFF, 1024}; pg8::StaticOrder S; S.init(rows, DFF, G, bid); S.wgm = FFN_WGM;
          EpiU E{P.ws, P.ffn_conv_w, P.ffn_conv_b, P.state_ffn, g0};
          pg8::gemm_phase<EpiU, pg8::StaticOrder, true, true>(lds, g, S, E); }
        GSYNC();
        for (int rep = 0; rep < DUPG6; ++rep)
        { pg8::Gemm g{(const bf16_t*)(P.ws + OFF_ACT), (const bf16_t*)(P.ws + OFF_WFOUT), rows, 1024, DFF}; pg8::StaticOrder S; S.init(rows, 1024, G, bid);
          EpiB16 E{(bf16_t*)(P.ws + OFF_F)};
          pg8::gemm_phase<EpiB16, pg8::StaticOrder, true, true>(lds, g, S, E); }
        GSYNC();
        rowpass3(P, g0, rows);
    }
}

extern "C" void kernel_launch(void* const* d_in, const int* in_sizes, int n_in, void* d_out, int out_size, void* d_ws, size_t ws_size, hipStream_t stream) {
    static int grid = 0;
    if (grid == 0) {
        if (n_in != 30 || (size_t)out_size != OUT_TOTAL || ws_size < WS_END) {
            fprintf(stderr, "kernel_launch: unexpected shapes: n_in %d out %d (want %zu) ws %zu (need %zu)\n", n_in, out_size, (size_t)OUT_TOTAL, ws_size, (size_t)WS_END); grid = -1; return; }
        int dev = 0, cus = 0, per_cu = 0;
        hipGetDevice(&dev); hipDeviceGetAttribute(&cus, hipDeviceAttributeMultiprocessorCount, dev);
        if (hipFuncSetAttribute((const void*)fwd_megakernel, hipFuncAttributeMaxDynamicSharedMemorySize, LDS_BYTES) != hipSuccess) { fprintf(stderr, "kernel_launch: hipFuncSetAttribute failed\n"); grid = -1; return; }
        if (hipOccupancyMaxActiveBlocksPerMultiprocessor(&per_cu, (const void*)fwd_megakernel, 512, LDS_BYTES) != hipSuccess || per_cu < 1) { fprintf(stderr, "kernel_launch: occupancy query says %d\n", per_cu); per_cu = 1; }
        (void)hipGetLastError();
        grid = cus;
        if (grid < 128) { fprintf(stderr, "kernel_launch: needs >= 128 CUs, got %d\n", grid); grid = -1; return; }
    }
    if (grid < 0) return;
    Params p{};
    const float** pp = (const float**)&p;
    for (int i = 0; i < 30; ++i) pp[i] = (const float*)d_in[i];
    p.out = (float*)d_out; p.ws = (unsigned char*)d_ws;
    void* args[] = {&p};
    hipError_t e = hipLaunchCooperativeKernel((const void*)fwd_megakernel, dim3(grid), dim3(512), args, LDS_BYTES, stream);
    if (e != hipSuccess) fprintf(stderr, "cooperative launch failed: %s (grid %d)\n", hipGetErrorString(e), grid);
}
```
